# Optimizing an MI355X kernel written in HIP

```python
import math
import jax, jax.numpy as jnp
from jax import lax
import numpy as np

D_MODEL = 1024
BATCH = 4
SEQ = 4096
DEPTH = 1

MEM_LEN = 256
SSD_HEADS = 16
SSD_HEAD_DIM = 64
SSD_INNER = SSD_HEADS * SSD_HEAD_DIM
SSD_GROUPS = 4
SSD_STATE = 128
SSD_CONV = 4
SSD_CHUNK = 128
SSD_XBC = SSD_INNER + 2 * SSD_GROUPS * SSD_STATE
ATT_HEADS = 16
ATT_HEAD_DIM = 64
ATT_WIDTH = ATT_HEADS * ATT_HEAD_DIM
KV_RANK = 256
IDX_HEADS = 16
IDX_DIM = 64
TOPK_MAX = 256
Q_BLOCK = 128
MEM_HEADS = 4
MEM_HEAD_DIM = D_MODEL // MEM_HEADS
D_FF = 2816
ALPHA = (2.0 * DEPTH) ** 0.25
BETA = (8.0 * DEPTH) ** -0.25
LN_EPS = 1e-5
RMS_EPS = 1e-6
IN_SPLITS = (D_MODEL, D_MODEL, SSD_INNER, SSD_XBC, SSD_HEADS,
             ATT_WIDTH, KV_RANK, IDX_HEADS * IDX_DIM, IDX_DIM, IDX_HEADS)
D_IN = 2 * D_MODEL + SSD_INNER + SSD_XBC + SSD_HEADS + ATT_WIDTH + KV_RANK + IDX_HEADS * IDX_DIM + IDX_DIM + IDX_HEADS

kernel_name = "hybrid_ssd_dsa_gated_macaron_deepnorm"


def layer_norm(x, g, b):
    xf = x.astype(jnp.float32)
    mu = jnp.mean(xf, -1, keepdims=True)
    var = jnp.mean(jnp.square(xf - mu), -1, keepdims=True)
    return ((xf - mu) * lax.rsqrt(var + LN_EPS) * g + b).astype(x.dtype)


def rms_norm(x, g):
    xf = x.astype(jnp.float32)
    y = xf * lax.rsqrt(jnp.mean(jnp.square(xf), -1, keepdims=True) + RMS_EPS)
    return (y * g).astype(x.dtype)


def swiglu_ffn(x, w_in, w_out):
    gate, up = jnp.split(x @ w_in, 2, axis=-1)
    return (jax.nn.silu(gate) * up) @ w_out


def split_cols(h, sizes):
    out, off = [], 0
    for s in sizes:
        out.append(h[..., off:off + s])
        off += s
    return out


def causal_dwconv(u, w, b):
    width, ch = w.shape
    out = lax.conv_general_dilated(u, w[:, None, :], window_strides=(1,),
                                   padding=[(width - 1, 0)],
                                   dimension_numbers=('NWC', 'WIO', 'NWC'),
                                   feature_group_count=ch)
    return out + b


def segsum(a):
    l = a.shape[-1]
    cs = jnp.cumsum(a, axis=-1)
    diff = cs[..., :, None] - cs[..., None, :]
    mask = jnp.tril(jnp.ones((l, l), dtype=bool))
    return jnp.where(mask, diff, -jnp.inf)


def ssd_chunked_scan(x, dt, a_head, bmat, cmat):
    bsz, seqlen, n_heads, p = x.shape
    g, n = bmat.shape[2], bmat.shape[3]
    r = n_heads // g
    l = SSD_CHUNK
    c = seqlen // l
    x = x.astype(jnp.float32).reshape(bsz, c, l, g, r, p)
    dt = dt.reshape(bsz, c, l, g, r)
    bmat = bmat.astype(jnp.float32).reshape(bsz, c, l, g, n)
    cmat = cmat.astype(jnp.float32).reshape(bsz, c, l, g, n)
    a = (dt * a_head.reshape(g, r)).transpose(0, 3, 4, 1, 2)
    a_cs = jnp.cumsum(a, axis=-1)
    xdt = x * dt[..., None]
    decay_in = jnp.exp(segsum(a))
    cb = jnp.einsum('bclgn,bcsgn->bcgls', cmat, bmat)
    y_diag = jnp.einsum('bcgls,bgrcls,bcsgrp->bclgrp', cb, decay_in, xdt)
    decay_to_end = jnp.exp(a_cs[..., -1:] - a_cs)
    chunk_states = jnp.einsum('bclgn,bgrcl,bclgrp->bcgrpn', bmat, decay_to_end, xdt)
    chunk_decay = jnp.exp(a_cs[..., -1])

    def step(h, inp):
        s_c, d_c = inp
        return d_c[..., None, None] * h + s_c, h

    h0 = jnp.zeros((bsz, g, r, p, n), jnp.float32)
    _, prev = lax.scan(step, h0, (jnp.moveaxis(chunk_states, 1, 0),
                                  jnp.moveaxis(chunk_decay, -1, 0)))
    prev = jnp.moveaxis(prev, 0, 1)
    y_off = jnp.einsum('bclgn,bcgrpn,bgrcl->bclgrp', cmat, prev, jnp.exp(a_cs))
    return (y_diag + y_off).reshape(bsz, seqlen, n_heads, p)


def ssd_branch(z, xbc, dt_raw, conv_w, conv_b, dt_bias, a_log, d_skip, norm_w):
    bsz, seqlen, _ = z.shape
    xbc = jax.nn.silu(causal_dwconv(xbc, conv_w, conv_b))
    gn = SSD_GROUPS * SSD_STATE
    xs, bm, cm = split_cols(xbc, (SSD_INNER, gn, gn))
    xh = xs.reshape(bsz, seqlen, SSD_HEADS, SSD_HEAD_DIM)
    dt = jax.nn.softplus(dt_raw.astype(jnp.float32) + dt_bias)
    a_head = -jnp.exp(a_log.astype(jnp.float32))
    y = ssd_chunked_scan(xh, dt, a_head,
                         bm.reshape(bsz, seqlen, SSD_GROUPS, SSD_STATE),
                         cm.reshape(bsz, seqlen, SSD_GROUPS, SSD_STATE))
    y = y + d_skip[None, None, :, None] * xh.astype(jnp.float32)
    y = y.reshape(bsz, seqlen, SSD_INNER) * jax.nn.silu(z.astype(jnp.float32))
    yg = y.reshape(bsz, seqlen, SSD_GROUPS, SSD_INNER // SSD_GROUPS)
    yg = yg * lax.rsqrt(jnp.mean(jnp.square(yg), -1, keepdims=True) + RMS_EPS)
    return (yg.reshape(bsz, seqlen, SSD_INNER) * norm_w).astype(z.dtype)


def dsa_branch(q, c_kv, q_idx, k_idx, w_idx, kv_norm_w, w_uk, w_uv):
    bsz, seqlen, _ = q.shape
    topk = min(TOPK_MAX, seqlen // 4)
    n_blocks = seqlen // Q_BLOCK
    q = q.reshape(bsz, seqlen, ATT_HEADS, ATT_HEAD_DIM)
    q_lat = jnp.einsum('bthd,hdr->bthr', q, w_uk) * (ATT_HEAD_DIM ** -0.5)
    c_kv = rms_norm(c_kv, kv_norm_w)
    q_idx = q_idx.reshape(bsz, seqlen, IDX_HEADS, IDX_DIM)
    w_idx = w_idx * (IDX_HEADS ** -0.5)
    slopes = 2.0 ** (-8.0 * jnp.arange(1, ATT_HEADS + 1, dtype=jnp.float32) / ATT_HEADS)
    key_pos = jnp.arange(seqlen, dtype=jnp.int32)

    def to_blocks(a):
        return a.reshape(bsz, n_blocks, Q_BLOCK, *a.shape[2:]).swapaxes(0, 1)

    t_blocks = key_pos.reshape(n_blocks, Q_BLOCK)

    def block(args):
        ql, qi, wi, t = args
        logits = jax.nn.relu(jnp.einsum('bqhd,bsd->bqhs', qi, k_idx))
        score = jnp.einsum('bqhs,bqh->bqs', logits, wi).astype(jnp.float32)
        causal = key_pos[None, :] <= t[:, None]
        score = jnp.where(causal[None], score, -jnp.inf)
        _, idx = lax.top_k(score, topk)
        sel = jax.vmap(lambda c, i: c[i])(c_kv, idx)
        s = jnp.einsum('bqhr,bqkr->bqhk', ql, sel).astype(jnp.float32)
        dist = (t[None, :, None] - idx).astype(jnp.float32)
        s = s - slopes[None, None, :, None] * dist[:, :, None, :]
        valid = idx <= t[None, :, None]
        s = jnp.where(valid[:, :, None, :], s, -jnp.inf)
        p = jax.nn.softmax(s, axis=-1).astype(sel.dtype)
        return jnp.einsum('bqhk,bqkr->bqhr', p, sel)

    o = lax.map(block, (to_blocks(q_lat), to_blocks(q_idx), to_blocks(w_idx), t_blocks))
    o = o.swapaxes(0, 1).reshape(bsz, seqlen, ATT_HEADS, KV_RANK)
    return jnp.einsum('bthr,hrd->bthd', o, w_uv).reshape(bsz, seqlen, ATT_WIDTH)


def memory_xattn(x, mem, w_mq, w_mkv, w_mo):
    bsz, seqlen, _ = x.shape
    q = (x @ w_mq).reshape(bsz, seqlen, MEM_HEADS, MEM_HEAD_DIM)
    k, v = jnp.split(mem @ w_mkv, 2, axis=-1)
    k = k.reshape(bsz, -1, MEM_HEADS, MEM_HEAD_DIM)
    v = v.reshape(bsz, -1, MEM_HEADS, MEM_HEAD_DIM)
    s = jnp.einsum('bthd,bmhd->bhtm', q, k).astype(jnp.float32) * (MEM_HEAD_DIM ** -0.5)
    p = jax.nn.softmax(s, axis=-1).astype(v.dtype)
    o = jnp.einsum('bhtm,bmhd->bthd', p, v).reshape(bsz, seqlen, D_MODEL)
    return o @ w_mo


def hybrid_layer(x, mem, ffn1_w_in, ffn1_w_out, ln1_g, ln1_b,
                 w_in, conv_w, conv_b, dt_bias, a_log, d_skip, ssd_norm_w,
                 kv_norm_w, w_uk, w_uv, w_proj_ssd, w_proj_att, w_out, ln2_g, ln2_b,
                 w_mq, w_mkv, w_mo, ln3_g, ln3_b,
                 ffn2_w_in, ffn2_w_out, ln4_g, ln4_b):
    x = layer_norm(ALPHA * x + 0.5 * swiglu_ffn(x, ffn1_w_in, ffn1_w_out), ln1_g, ln1_b)
    h = x @ w_in
    g_ssd, g_att, z, xbc, dt_raw, q, c_kv, q_idx, k_idx, w_idx = split_cols(h, IN_SPLITS)
    y_ssd = ssd_branch(z, xbc, dt_raw, conv_w, conv_b, dt_bias, a_log, d_skip, ssd_norm_w)
    y_att = dsa_branch(q, c_kv, q_idx, k_idx, w_idx, kv_norm_w, w_uk, w_uv)
    merged = jax.nn.sigmoid(g_ssd) * (y_ssd @ w_proj_ssd) + jax.nn.sigmoid(g_att) * (y_att @ w_proj_att)
    x = layer_norm(ALPHA * x + merged @ w_out, ln2_g, ln2_b)
    x = layer_norm(ALPHA * x + memory_xattn(x, mem, w_mq, w_mkv, w_mo), ln3_g, ln3_b)
    x = layer_norm(ALPHA * x + 0.5 * swiglu_ffn(x, ffn2_w_in, ffn2_w_out), ln4_g, ln4_b)
    return x


def setup_inputs(seed: int = 0) -> dict:
    key = jax.random.key(seed)
    keys = iter(jax.random.split(key, 48))
    f32 = jnp.float32
    L = DEPTH

    def nrm(shape, scale):
        return jax.random.normal(next(keys), shape, f32) * scale

    def gain(shape):
        return 1.0 + nrm(shape, 0.02)

    x = nrm((BATCH, SEQ, D_MODEL), 1.0)
    mem = nrm((BATCH, MEM_LEN, D_MODEL), 1.0)
    ffn1_w_in = nrm((L, D_MODEL, 2 * D_FF), D_MODEL ** -0.5)
    ffn1_w_out = nrm((L, D_FF, D_MODEL), BETA * D_FF ** -0.5)
    ln1_g = gain((L, D_MODEL))
    ln1_b = nrm((L, D_MODEL), 0.02)
    w_in = nrm((L, D_MODEL, D_IN), D_MODEL ** -0.5)
    conv_w = nrm((L, SSD_CONV, SSD_XBC), SSD_CONV ** -0.5)
    conv_b = nrm((L, SSD_XBC), 0.02)
    dt0 = jnp.exp(jax.random.uniform(next(keys), (L, SSD_HEADS), f32,
                                     minval=math.log(1e-3), maxval=math.log(1e-1)))
    dt_bias = dt0 + jnp.log(-jnp.expm1(-dt0))
    a_log = jnp.log(jax.random.uniform(next(keys), (L, SSD_HEADS), f32, minval=1.0, maxval=16.0))
    d_skip = gain((L, SSD_HEADS))
    ssd_norm_w = gain((L, SSD_INNER))
    kv_norm_w = gain((L, KV_RANK))
    w_uk = nrm((L, ATT_HEADS, ATT_HEAD_DIM, KV_RANK), KV_RANK ** -0.5)
    w_uv = nrm((L, ATT_HEADS, KV_RANK, ATT_HEAD_DIM), KV_RANK ** -0.5)
    w_proj_ssd = nrm((L, SSD_INNER, D_MODEL), SSD_INNER ** -0.5)
    w_proj_att = nrm((L, ATT_WIDTH, D_MODEL), ATT_WIDTH ** -0.5)
    w_out = nrm((L, D_MODEL, D_MODEL), BETA * D_MODEL ** -0.5)
    ln2_g = gain((L, D_MODEL))
    ln2_b = nrm((L, D_MODEL), 0.02)
    w_mq = nrm((L, D_MODEL, D_MODEL), D_MODEL ** -0.5)
    w_mkv = nrm((L, D_MODEL, 2 * D_MODEL), D_MODEL ** -0.5)
    w_mo = nrm((L, D_MODEL, D_MODEL), BETA * D_MODEL ** -0.5)
    ln3_g = gain((L, D_MODEL))
    ln3_b = nrm((L, D_MODEL), 0.02)
    ffn2_w_in = nrm((L, D_MODEL, 2 * D_FF), D_MODEL ** -0.5)
    ffn2_w_out = nrm((L, D_FF, D_MODEL), BETA * D_FF ** -0.5)
    ln4_g = gain((L, D_MODEL))
    ln4_b = nrm((L, D_MODEL), 0.02)
    return {"x": x, "mem": mem,
            "ffn1_w_in": ffn1_w_in, "ffn1_w_out": ffn1_w_out, "ln1_g": ln1_g, "ln1_b": ln1_b,
            "w_in": w_in, "conv_w": conv_w, "conv_b": conv_b, "dt_bias": dt_bias,
            "a_log": a_log, "d_skip": d_skip, "ssd_norm_w": ssd_norm_w,
            "kv_norm_w": kv_norm_w, "w_uk": w_uk, "w_uv": w_uv,
            "w_proj_ssd": w_proj_ssd, "w_proj_att": w_proj_att, "w_out": w_out,
            "ln2_g": ln2_g, "ln2_b": ln2_b,
            "w_mq": w_mq, "w_mkv": w_mkv, "w_mo": w_mo, "ln3_g": ln3_g, "ln3_b": ln3_b,
            "ffn2_w_in": ffn2_w_in, "ffn2_w_out": ffn2_w_out, "ln4_g": ln4_g, "ln4_b": ln4_b}


def reference(x, mem, ffn1_w_in, ffn1_w_out, ln1_g, ln1_b,
              w_in, conv_w, conv_b, dt_bias, a_log, d_skip, ssd_norm_w,
              kv_norm_w, w_uk, w_uv, w_proj_ssd, w_proj_att, w_out, ln2_g, ln2_b,
              w_mq, w_mkv, w_mo, ln3_g, ln3_b,
              ffn2_w_in, ffn2_w_out, ln4_g, ln4_b):
    for layer in range(DEPTH):
        x = hybrid_layer(x, mem,
                         ffn1_w_in[layer], ffn1_w_out[layer], ln1_g[layer], ln1_b[layer],
                         w_in[layer], conv_w[layer], conv_b[layer], dt_bias[layer],
                         a_log[layer], d_skip[layer], ssd_norm_w[layer],
                         kv_norm_w[layer], w_uk[layer], w_uv[layer],
                         w_proj_ssd[layer], w_proj_att[layer], w_out[layer],
                         ln2_g[layer], ln2_b[layer],
                         w_mq[layer], w_mkv[layer], w_mo[layer], ln3_g[layer], ln3_b[layer],
                         ffn2_w_in[layer], ffn2_w_out[layer], ln4_g[layer], ln4_b[layer])
    return x
```

```cpp
#include <hip/hip_runtime.h>
#include <cstdio>
#include <cstdint>
namespace pg8 {
#define PG8_LAS __attribute__((address_space(3)))
typedef unsigned short bf16_t;
typedef short bf16x8 __attribute__((ext_vector_type(8)));
typedef float f32x4 __attribute__((ext_vector_type(4)));
typedef unsigned u32x4 __attribute__((ext_vector_type(4)));
constexpr int BM = 256, BK = 64, HALF = 128, HTB = HALF * BK * 2  , STAGE_BYTES = 8 * HTB, NXCD = 8, WGM = 8;

__host__ __device__ __forceinline__ int lds_byte(int r, int c) { const int st = (r >> 4) * 2 + (c >> 5), rr = r & 15, cc = c & 31, ob = rr * 64 + cc * 2; return st * 1024 + (ob ^ (((ob >> 9) & 1) << 5)); }
__host__ __device__ __forceinline__ void stage_rc(int b, int& R, int& C) { const int st = b / 1024, sb = b % 1024, swz = sb ^ (((sb >> 9) & 1) << 5); R = (st >> 1) * 16 + swz / 64; C = (st & 1) * 32 + (swz % 64) / 2; }
__host__ __device__ __forceinline__ int perm32(int rho) { const int n = rho >> 4, i = rho & 15; return 8 * (i >> 2) + 4 * n + (i & 3); }

struct Unit { int pm, pn; };
struct Gemm { const bf16_t* A; const bf16_t* Bt; int M, N, K; };

struct StaticOrder {
    int nM, nN, nwg, G, c;
    __host__ __device__ void init(int M, int N, int G_, int c_) { nM = M / BM; nN = N / BM; nwg = nM * nN; G = G_; c = c_; }
    __host__ __device__ bool next(int i, Unit& u) const {
        const long L = (long)i * G + c; if (L >= nwg) return false;
        int wgid = (int)L; { const int q = nwg / NXCD, r = nwg % NXCD, xcd = wgid % NXCD, off = wgid / NXCD; wgid = (xcd < r ? xcd * (q + 1) : r * (q + 1) + (xcd - r) * q) + off; }
        const int nig = WGM * nN, gid = wgid / nig, fm = gid * WGM, gsz = (nM - fm) < WGM ? (nM - fm) : WGM;
        u.pm = fm + ((wgid % nig) % gsz); u.pn = (wgid % nig) / gsz; return true;
    }
    __device__ __forceinline__ void a_ready(const Unit&) const {}
    __device__ __forceinline__ void done(const Unit&) const {}
};

typedef float f32x2 __attribute__((ext_vector_type(2)));
typedef __bf16 bf16x2_t __attribute__((ext_vector_type(2)));
__device__ __forceinline__ unsigned cvt_pk_bf16(float lo, float hi) { f32x2 v = {lo, hi}; bf16x2_t b = __builtin_convertvector(v, bf16x2_t); return __builtin_bit_cast(unsigned, b); }
typedef unsigned u32x2 __attribute__((ext_vector_type(2)));
__device__ __forceinline__ float sigm(float x) { return __builtin_amdgcn_rcpf(1.f + __expf(-x)); }
__device__ __forceinline__ float silu(float x) { return x * sigm(x); }
__device__ __forceinline__ float bf_lo(unsigned w) { return __uint_as_float(w << 16); }
__device__ __forceinline__ float bf_hi(unsigned w) { return __uint_as_float(w & 0xffff0000u); }
__device__ __forceinline__ u32x4 pack8(const float (&h)[8]) { u32x4 w; w.x = cvt_pk_bf16(h[0], h[1]); w.y = cvt_pk_bf16(h[2], h[3]); w.z = cvt_pk_bf16(h[4], h[5]); w.w = cvt_pk_bf16(h[6], h[7]); return w; }
__device__ __forceinline__ void unpack8(u32x4 w, float (&h)[8]) { h[0] = bf_lo(w.x); h[1] = bf_hi(w.x); h[2] = bf_lo(w.y); h[3] = bf_hi(w.y); h[4] = bf_lo(w.z); h[5] = bf_hi(w.z); h[6] = bf_lo(w.w); h[7] = bf_hi(w.w); }

struct EpiSwiglu {
    static constexpr bool PERM = true, AFTER_DRAIN = false;
    bf16_t* O; int ldo;
    __device__ __forceinline__ void operator()(const f32x4 (&acc)[2][2][4][2], const Unit& u, int wr, int wc, int fr, int fq) const {
        const int row0 = u.pm * BM + wr * 64 + fr, col0 = u.pn * 128 + wc * 32 + 8 * fq;
#pragma unroll
        for (int ai = 0; ai < 2; ++ai)
#pragma unroll
            for (int m = 0; m < 4; ++m) {
                float h[8];
#pragma unroll
                for (int n = 0; n < 2; ++n)
#pragma unroll
                    for (int i = 0; i < 4; ++i) h[n * 4 + i] = silu(acc[ai][0][m][n][i]) * acc[ai][1][m][n][i];
                *(u32x4*)(O + (size_t)(row0 + ai * HALF + m * 16) * ldo + col0) = pack8(h);
            }
    }
};
struct EpiPlain {
    static constexpr bool PERM = true, AFTER_DRAIN = false;
    bf16_t* O; int ldo;
    __device__ __forceinline__ void operator()(const f32x4 (&acc)[2][2][4][2], const Unit& u, int wr, int wc, int fr, int fq) const {
        const int row0 = u.pm * BM + wr * 64 + fr, col0 = u.pn * BM + wc * 32 + 8 * fq;
#pragma unroll
        for (int ai = 0; ai < 2; ++ai)
#pragma unroll
            for (int m = 0; m < 4; ++m)
#pragma unroll
                for (int bj = 0; bj < 2; ++bj) {
                    float h[8];
#pragma unroll
                    for (int n = 0; n < 2; ++n)
#pragma unroll
                        for (int i = 0; i < 4; ++i) h[n * 4 + i] = acc[ai][bj][m][n][i];
                    *(u32x4*)(O + (size_t)(row0 + ai * HALF + m * 16) * ldo + col0 + bj * HALF) = pack8(h);
                }
    }
};
template <bool BASE_BF16> struct EpiRes {
    static constexpr bool PERM = true, AFTER_DRAIN = false;
    const void* base; float* V; float alpha, scale;
    __device__ __forceinline__ void operator()(const f32x4 (&acc)[2][2][4][2], const Unit& u, int wr, int wc, int fr, int fq) const {
        const int row0 = u.pm * BM + wr * 64 + fr, col0 = u.pn * BM + wc * 32 + 8 * fq;
#pragma unroll
        for (int ai = 0; ai < 2; ++ai)
#pragma unroll
            for (int m = 0; m < 4; ++m)
#pragma unroll
                for (int bj = 0; bj < 2; ++bj) {
                    const size_t off = (size_t)(row0 + ai * HALF + m * 16) * 1024 + col0 + bj * HALF;
                    float b[8];
                    if (BASE_BF16) { unpack8(*(const u32x4*)((const bf16_t*)base + off), b); }
                    else { const f32x4 b0 = *(const f32x4*)((const float*)base + off), b1 = *(const f32x4*)((const float*)base + off + 4);
                        b[0] = b0[0]; b[1] = b0[1]; b[2] = b0[2]; b[3] = b0[3]; b[4] = b1[0]; b[5] = b1[1]; b[6] = b1[2]; b[7] = b1[3]; }
                    f32x4 v0, v1;
#pragma unroll
                    for (int i = 0; i < 4; ++i) { v0[i] = alpha * b[i] + scale * acc[ai][bj][m][0][i]; v1[i] = alpha * b[4 + i] + scale * acc[ai][bj][m][1][i]; }
                    *(f32x4*)(V + off) = v0; *(f32x4*)(V + off + 4) = v1;
                }
    }
};
struct EpiInproj {
    static constexpr bool PERM = true, AFTER_DRAIN = false;
    bf16_t *ZS, *XBC, *Q, *QI, *KIDX; float *CKV, *DT, *WIDX; const float* dt_bias;
    __device__ __forceinline__ void operator()(const f32x4 (&acc)[2][2][4][2], const Unit& u, int wr, int wc, int fr, int fq) const {
        const int row0 = u.pm * BM + wr * 64 + fr, lc0 = wc * 32 + 8 * fq, pn = u.pn;
#pragma unroll
        for (int ai = 0; ai < 2; ++ai)
#pragma unroll
            for (int m = 0; m < 4; ++m)
#pragma unroll
                for (int bj = 0; bj < 2; ++bj) {
                    const size_t row = (size_t)(row0 + ai * HALF + m * 16); const int lc = lc0 + bj * HALF;
                    float h[8];
#pragma unroll
                    for (int n = 0; n < 2; ++n)
#pragma unroll
                        for (int i = 0; i < 4; ++i) h[n * 4 + i] = acc[ai][bj][m][n][i];
                    if (pn < 4) {
#pragma unroll
                        for (int i = 0; i < 8; ++i) h[i] = silu(h[i]);
                        *(u32x4*)(ZS + row * 1024 + pn * 256 + lc) = pack8(h);
                    } else if (pn < 12) { *(u32x4*)(XBC + row * 2048 + (pn - 4) * 256 + lc) = pack8(h);
                    } else if (pn < 16) { *(u32x4*)(Q + row * 1024 + (pn - 12) * 256 + lc) = pack8(h);
                    } else if (pn < 20) { *(u32x4*)(QI + row * 1024 + (pn - 16) * 256 + lc) = pack8(h);
                    } else if (pn == 20) { *(f32x4*)(CKV + row * 256 + lc) = (f32x4){h[0], h[1], h[2], h[3]}; *(f32x4*)(CKV + row * 256 + lc + 4) = (f32x4){h[4], h[5], h[6], h[7]};
                    } else {
                        if (lc < 64) { *(u32x4*)(KIDX + row * 64 + lc) = pack8(h); }
                        else if (lc < 80) { const int h0 = lc - 64; float d[8];
#pragma unroll
                            for (int i = 0; i < 8; ++i) { const float xx = h[i] + dt_bias[h0 + i]; d[i] = xx > 20.f ? xx : __logf(1.f + __expf(xx)); }
                            *(f32x4*)(DT + row * 16 + h0) = (f32x4){d[0], d[1], d[2], d[3]}; *(f32x4*)(DT + row * 16 + h0 + 4) = (f32x4){d[4], d[5], d[6], d[7]}; }
                        else if (lc < 96) { const int h0 = lc - 80;
                            *(f32x4*)(WIDX + row * 16 + h0) = (f32x4){h[0] * 0.25f, h[1] * 0.25f, h[2] * 0.25f, h[3] * 0.25f}; *(f32x4*)(WIDX + row * 16 + h0 + 4) = (f32x4){h[4] * 0.25f, h[5] * 0.25f, h[6] * 0.25f, h[7] * 0.25f}; }
                    }
                }
    }
};
template <int MODE> struct EpiMerge {
    static constexpr bool PERM = true, AFTER_DRAIN = false;
    bf16_t* G; float* Sm; bf16_t* Out;
    __device__ __forceinline__ void operator()(const f32x4 (&acc)[2][2][4][2], const Unit& u, int wr, int wc, int fr, int fq) const {
        const int row0 = u.pm * BM + wr * 64 + fr, col0 = u.pn * BM + wc * 32 + 8 * fq;
#pragma unroll
        for (int ai = 0; ai < 2; ++ai)
#pragma unroll
            for (int m = 0; m < 4; ++m)
#pragma unroll
                for (int bj = 0; bj < 2; ++bj) {
                    const size_t off = (size_t)(row0 + ai * HALF + m * 16) * 1024 + col0 + bj * HALF;
                    float h[8];
#pragma unroll
                    for (int n = 0; n < 2; ++n)
#pragma unroll
                        for (int i = 0; i < 4; ++i) h[n * 4 + i] = acc[ai][bj][m][n][i];
                    if (MODE == 0) {
#pragma unroll
                        for (int i = 0; i < 8; ++i) h[i] = sigm(h[i]);
                        *(u32x4*)(G + off) = pack8(h);
                    } else if (MODE == 1) { float g[8]; unpack8(*(const u32x4*)(G + off), g);
                        *(f32x4*)(Sm + off) = (f32x4){g[0] * h[0], g[1] * h[1], g[2] * h[2], g[3] * h[3]}; *(f32x4*)(Sm + off + 4) = (f32x4){g[4] * h[4], g[5] * h[5], g[6] * h[6], g[7] * h[7]};
                    } else { float g[8]; unpack8(*(const u32x4*)(G + off), g); const f32x4 s0 = *(const f32x4*)(Sm + off), s1 = *(const f32x4*)(Sm + off + 4);
#pragma unroll
                        for (int i = 0; i < 4; ++i) { h[i] = s0[i] + g[i] * h[i]; h[4 + i] = s1[i] + g[4 + i] * h[4 + i]; }
                        *(u32x4*)(Out + off) = pack8(h); }
                }
    }
};
template <class Epi, class Sched, bool ALIGN_EPI = false, bool SP2 = false>
__device__ __forceinline__ void gemm_phase(PG8_LAS unsigned char* lds, const Gemm g, const Sched& S, const Epi& E) {
    const int tid = threadIdx.x, wid = __builtin_amdgcn_readfirstlane(tid >> 6), lane = tid & 63, wr = wid >> 2, wc = wid & 3, fr = lane & 15, fq = lane >> 4;
    const int K = g.K, nt = K / BK;
    unsigned voffA[2], voffB[2];
#pragma unroll
    for (int i = 0; i < 2; ++i) { int R, C; stage_rc(tid * 16 + i * 8192, R, C); const int Rb = Epi::PERM ? ((R & ~31) + perm32(R & 31)) : R;
        voffA[i] = (unsigned)(R * K + C) * 2u; voffB[i] = (unsigned)(Rb * K + C) * 2u; }
    const size_t kstep = (size_t)(BK * 2);
    const size_t hstep = (size_t)HALF * K * 2;
    const size_t tstep = 2 * hstep;
    const unsigned ldsw = (unsigned)wid * 1024u;
    const int aoff = lds_byte(wr * 64 + fr, fq * 8), boff = lds_byte(wc * 32 + fr, fq * 8);
#define PG8_SA(b, h) (((b) * 2 + (h)) * HTB)
#define PG8_SB(b, h) ((4 + (b) * 2 + (h)) * HTB)
#define PG8_STAGE(bufoff, gbase, voff) do { _Pragma("unroll") for (int _i = 0; _i < 2; ++_i) \
        __builtin_amdgcn_global_load_lds((const unsigned*)((const char*)(gbase) + (voff)[_i]), (PG8_LAS unsigned*)(lds + (bufoff) + ldsw + _i * 8192), 16, 0, 0); } while (0)
#define PG8_LDA(dst, b, h) do { _Pragma("unroll") for (int m = 0; m < 4; ++m) _Pragma("unroll") for (int k = 0; k < 2; ++k) dst[m][k] = *(const PG8_LAS bf16x8*)(lds + PG8_SA(b, h) + aoff + m * 2048 + k * 1024); } while (0)
#define PG8_LDB(dst, b, h) do { _Pragma("unroll") for (int n = 0; n < 2; ++n) _Pragma("unroll") for (int k = 0; k < 2; ++k) dst[n][k] = *(const PG8_LAS bf16x8*)(lds + PG8_SB(b, h) + boff + n * 2048 + k * 1024); } while (0)
#define PG8_MMA(ai, bj, At, Bt) do { __builtin_amdgcn_s_setprio(1); _Pragma("unroll") for (int m = 0; m < 4; ++m) _Pragma("unroll") for (int n = 0; n < 2; ++n) _Pragma("unroll") for (int k = 0; k < 2; ++k) \
        acc[ai][bj][m][n] = __builtin_amdgcn_mfma_f32_16x16x32_bf16(Bt[n][k], At[m][k], acc[ai][bj][m][n], 0, 0, 0); __builtin_amdgcn_s_setprio(0); } while (0)
#define PG8_WAIT_V(n) asm volatile("s_waitcnt vmcnt(" #n ")" ::: "memory")
#define PG8_WAIT_L(n) asm volatile("s_waitcnt lgkmcnt(" #n ")" ::: "memory")
#define PG8_BAR __builtin_amdgcn_s_barrier()
#define PG8_SCHED __builtin_amdgcn_sched_barrier(0)
    Unit cur, nxt; int ui = 0;
    if (!S.next(0, cur)) return;
    f32x4 acc[2][2][4][2];
#pragma unroll
    for (int a = 0; a < 2; ++a)
#pragma unroll
        for (int b = 0; b < 2; ++b)
#pragma unroll
            for (int m = 0; m < 4; ++m)
#pragma unroll
                for (int n = 0; n < 2; ++n) acc[a][b][m][n] = (f32x4){0.f, 0.f, 0.f, 0.f};
    bf16x8 At[4][2], B0[2][2], B1[2][2];
    const char* cA = (const char*)g.A + (size_t)cur.pm * tstep; const char* cB = (const char*)g.Bt + (size_t)cur.pn * tstep;
    S.a_ready(cur);
    if constexpr (SP2) {
        PG8_STAGE(PG8_SB(0, 0), cB, voffB); PG8_STAGE(PG8_SB(0, 1), cB + hstep, voffB); PG8_STAGE(PG8_SA(0, 0), cA, voffA); PG8_STAGE(PG8_SA(0, 1), cA + hstep, voffA);
        if (wr == 1) PG8_BAR;
        PG8_WAIT_V(2); PG8_BAR;
        PG8_STAGE(PG8_SB(1, 0), cB + kstep, voffB); PG8_STAGE(PG8_SA(1, 0), cA + kstep, voffA); PG8_STAGE(PG8_SB(1, 1), cB + hstep + kstep, voffB);
        PG8_WAIT_V(6); PG8_BAR;
    } else {
        PG8_STAGE(PG8_SB(0, 0), cB, voffB); PG8_STAGE(PG8_SA(0, 0), cA, voffA); PG8_STAGE(PG8_SB(0, 1), cB + hstep, voffB); PG8_STAGE(PG8_SA(0, 1), cA + hstep, voffA);
        if (wr == 1) PG8_BAR;
        PG8_WAIT_V(4); PG8_BAR;
        PG8_STAGE(PG8_SB(1, 0), cB + kstep, voffB); PG8_STAGE(PG8_SA(1, 0), cA + kstep, voffA); PG8_STAGE(PG8_SB(1, 1), cB + hstep + kstep, voffB);
        PG8_WAIT_V(6); PG8_BAR;
    }
    for (;;) {
        const bool has_next = S.next(ui + 1, nxt);
        const char* nA = has_next ? (const char*)g.A + (size_t)nxt.pm * tstep : cA; const char* nB = has_next ? (const char*)g.Bt + (size_t)nxt.pn * tstep : cB;
        for (int t = 0; t < nt; t += 2) {
            const bool last = (t == nt - 2);
            const char* a1 = cA + (size_t)(t + 1) * kstep;
            const char* a2 = last ? nA : cA + (size_t)(t + 2) * kstep; const char* b2 = last ? nB : cB + (size_t)(t + 2) * kstep;
            const char* a3 = a2 + kstep; const char* b3 = b2 + kstep;
            if (last && has_next) S.a_ready(nxt);
            if constexpr (SP2) {
            PG8_LDB(B0, 0, 0); PG8_LDB(B1, 0, 1); PG8_SCHED; PG8_LDA(At, 0, 0); PG8_STAGE(PG8_SA(1, 1), a1 + hstep, voffA);
            PG8_WAIT_V(8); PG8_WAIT_L(0); PG8_BAR; PG8_MMA(0, 0, At, B0); PG8_MMA(0, 1, At, B1); PG8_BAR; PG8_SCHED;
            PG8_LDA(At, 0, 1); PG8_STAGE(PG8_SB(0, 0), b2, voffB); PG8_STAGE(PG8_SB(0, 1), b2 + hstep, voffB); PG8_STAGE(PG8_SA(0, 0), a2, voffA);
            PG8_WAIT_V(8); PG8_WAIT_L(0); PG8_BAR; PG8_MMA(1, 0, At, B0); PG8_MMA(1, 1, At, B1); PG8_BAR; PG8_SCHED;
            PG8_LDB(B0, 1, 0); PG8_LDB(B1, 1, 1); PG8_SCHED; PG8_LDA(At, 1, 0); PG8_STAGE(PG8_SA(0, 1), a2 + hstep, voffA);
            PG8_WAIT_V(8); PG8_WAIT_L(0); PG8_BAR; PG8_MMA(0, 0, At, B0); PG8_MMA(0, 1, At, B1); PG8_BAR; PG8_SCHED;
            PG8_LDA(At, 1, 1); PG8_STAGE(PG8_SB(1, 0), b3, voffB); PG8_STAGE(PG8_SB(1, 1), b3 + hstep, voffB); PG8_STAGE(PG8_SA(1, 0), a3, voffA);
            PG8_WAIT_V(8); PG8_WAIT_L(0); PG8_BAR; PG8_MMA(1, 0, At, B0); PG8_MMA(1, 1, At, B1); PG8_BAR; PG8_SCHED;
            } else {
            PG8_LDB(B0, 0, 0); PG8_SCHED; PG8_LDA(At, 0, 0); PG8_STAGE(PG8_SA(1, 1), a1 + hstep, voffA);
            PG8_WAIT_L(8); PG8_BAR; PG8_WAIT_L(0); PG8_MMA(0, 0, At, B0); PG8_BAR; PG8_SCHED;
            PG8_LDB(B1, 0, 1); PG8_STAGE(PG8_SB(0, 0), b2, voffB);
            PG8_BAR; PG8_WAIT_L(0); PG8_MMA(0, 1, At, B1); PG8_BAR;
            PG8_LDA(At, 0, 1); PG8_STAGE(PG8_SA(0, 0), a2, voffA);
            PG8_BAR; PG8_WAIT_L(0); PG8_MMA(1, 0, At, B0); PG8_BAR; PG8_SCHED;
            PG8_STAGE(PG8_SB(0, 1), b2 + hstep, voffB);
            PG8_WAIT_V(6); PG8_BAR; PG8_MMA(1, 1, At, B1); PG8_BAR;
            PG8_LDB(B0, 1, 0); PG8_SCHED; PG8_LDA(At, 1, 0); PG8_STAGE(PG8_SA(0, 1), a2 + hstep, voffA);
            PG8_WAIT_L(8); PG8_BAR; PG8_WAIT_L(0); PG8_MMA(0, 0, At, B0); PG8_BAR; PG8_SCHED;
            PG8_LDB(B1, 1, 1); PG8_STAGE(PG8_SB(1, 0), b3, voffB);
            PG8_BAR; PG8_WAIT_L(0); PG8_MMA(0, 1, At, B1); PG8_BAR;
            PG8_LDA(At, 1, 1); PG8_STAGE(PG8_SA(1, 0), a3, voffA);
            PG8_BAR; PG8_WAIT_L(0); PG8_MMA(1, 0, At, B0); PG8_BAR; PG8_SCHED;
            PG8_STAGE(PG8_SB(1, 1), b3 + hstep, voffB);
            PG8_WAIT_V(6); PG8_BAR; PG8_MMA(1, 1, At, B1); PG8_BAR;
            }
        }
        if constexpr (ALIGN_EPI) { if (wr == 0) PG8_BAR; }
        if constexpr (!Epi::AFTER_DRAIN) { E(acc, cur, wr, wc, fr, fq); S.done(cur); }
        if (!has_next) break;
#pragma unroll
        for (int a = 0; a < 2; ++a)
#pragma unroll
            for (int b = 0; b < 2; ++b)
#pragma unroll
                for (int m = 0; m < 4; ++m)
#pragma unroll
                    for (int n = 0; n < 2; ++n) acc[a][b][m][n] = (f32x4){0.f, 0.f, 0.f, 0.f};
        cur = nxt; cA = nA; cB = nB; ++ui;
        if constexpr (ALIGN_EPI) { if (wr == 1) PG8_BAR; }
    }
    PG8_WAIT_V(0);
    if constexpr (!ALIGN_EPI) { if (wr == 0) PG8_BAR; }
    PG8_BAR;
    if constexpr (Epi::AFTER_DRAIN) { E.fused(acc, cur, wr, wc, fr, fq, lds, wid, lane); S.done(cur); }
#undef PG8_SA
#undef PG8_SB
#undef PG8_STAGE
#undef PG8_LDA
#undef PG8_LDB
#undef PG8_MMA
#undef PG8_WAIT_V
#undef PG8_WAIT_L
#undef PG8_BAR
#undef PG8_SCHED
}
}

#define LAS __attribute__((address_space(3)))
typedef unsigned short bf16;
typedef unsigned v4u __attribute__((ext_vector_type(4)));
typedef unsigned v2u __attribute__((ext_vector_type(2)));
typedef float f32x4 __attribute__((ext_vector_type(4)));
typedef float f32x2 __attribute__((ext_vector_type(2)));
constexpr int NWAVES = 8, NTHR = 512;
constexpr int BATCH = 4, SEQ = 4096, D = 1024, T = BATCH * SEQ, DFF = 2816, MEML = 256;
constexpr int NIN = 5632;
constexpr int WIN_LD = 7520;
constexpr float ALPHA = 1.189207115002721f;
constexpr float LN_EPS = 1e-5f, RMS_EPS = 1e-6f;
constexpr size_t MiB = 1u << 20;
constexpr size_t WS_CTL = 0;
constexpr size_t WS_WA_IN = 1 * MiB, WS_WA_OUT = 12 * MiB;
constexpr size_t WS_WIN = 18 * MiB;
constexpr size_t WS_WGS = 29 * MiB, WS_WGA = 31 * MiB, WS_WPS = 33 * MiB, WS_WPA = 35 * MiB, WS_WOUT = 37 * MiB, WS_WMQ = 39 * MiB, WS_WMO = 41 * MiB, WS_WMKV = 43 * MiB;
constexpr size_t WS_MEMB = 47 * MiB, WS_KVM = 49 * MiB;
constexpr size_t WS_WUK = 53 * MiB;
constexpr size_t WS_XB = 54 * MiB;
constexpr size_t WS_Z = 86 * MiB;
constexpr size_t WS_Q = 118 * MiB;
constexpr size_t WS_XBC = 150 * MiB;
constexpr size_t WS_QI = 214 * MiB;
constexpr size_t WS_CKVN = 246 * MiB;
constexpr size_t WS_KIDX = 254 * MiB;
constexpr size_t WS_H = 86 * MiB;
constexpr size_t WS_END = 256 * MiB;
constexpr size_t DO_CKV = 0, DO_DT = 16 * MiB, DO_WIDX = 17 * MiB, DO_IDX = 18 * MiB, DO_YB = 26 * MiB;
constexpr size_t DO_SG2 = 0, DO_MERGED = 32 * MiB;
constexpr int LDS_BYTES = 147456;

__device__ __forceinline__ unsigned f2bf(float f) { unsigned u = __builtin_bit_cast(unsigned, f); return (u + 0x7fffu + ((u >> 16) & 1u)) >> 16; }
__device__ __forceinline__ unsigned pk2(float lo, float hi) { return f2bf(lo) | (f2bf(hi) << 16); }
__device__ __forceinline__ float bflo(unsigned w) { return __uint_as_float(w << 16); }
__device__ __forceinline__ float bfhi(unsigned w) { return __uint_as_float(w & 0xffff0000u); }
__device__ __forceinline__ float bf2f(bf16 v) { return __uint_as_float(((unsigned)v) << 16); }
__device__ __forceinline__ float wave_sum(float v) {
#pragma unroll
    for (int o = 1; o < 64; o <<= 1) v += __shfl_xor(v, o);
    return v;
}
__device__ __forceinline__ float wave_max(float v) {
#pragma unroll
    for (int o = 1; o < 64; o <<= 1) v = fmaxf(v, __shfl_xor(v, o));
    return v;
}

struct Args { const float* in[30]; float* out; unsigned char* ws; int ph_lo, ph_hi; };
enum { I_X = 0, I_MEM, I_F1IN, I_F1OUT, I_LN1G, I_LN1B, I_WIN, I_CONVW, I_CONVB, I_DTB, I_ALOG, I_DSKIP, I_SSDNW, I_KVNW, I_WUK, I_WUV, I_WPS, I_WPA, I_WOUT, I_LN2G, I_LN2B,
       I_WMQ, I_WMKV, I_WMO, I_LN3G, I_LN3B, I_F2IN, I_F2OUT, I_LN4G, I_LN4B };

__device__ __forceinline__ int srccol(int mode, int n) {
    if (mode == 0) return n;
    if (mode == 1) { const int tile = n >> 8, w = n & 255; return (w >> 7) * DFF + tile * 128 + (w & 127); }
    if (mode == 2) {
        if (n < 1024) return 2048 + n;
        if (n < 3072) return 3072 + (n - 1024);
        if (n < 4096) return 5136 + (n - 3072);
        if (n < 5120) return 6416 + (n - 4096);
        if (n < 5376) return 6160 + (n - 5120);
        n -= 5376;
        if (n < 64) return 7440 + n;
        if (n < 80) return 5120 + (n - 64);
        if (n < 96) return 7504 + (n - 80);
        return -1;
    }
    if (mode == 3) return n;
    return 1024 + n;
}
__device__ __forceinline__ void transpose_item(const float* W, int K, int ldw, bf16* WT, int nout, int mode, float* scr, int item, int lane) {
    const int nblk = nout / 32, kb = item / nblk, nb = item % nblk, k0 = 64 * kb, n0 = 32 * nb;
    const int sc = srccol(mode, n0 + (lane & 31));
#pragma unroll 8
    for (int i = 0; i < 32; ++i) { const int kk = 2 * i + (lane >> 5); scr[kk * 33 + (lane & 31)] = sc >= 0 ? W[(size_t)(k0 + kk) * ldw + sc] : 0.f; }
    __builtin_amdgcn_s_waitcnt(0xc07f); asm volatile("" ::: "memory");
    const int c = lane & 7;
#pragma unroll
    for (int j = 0; j < 4; ++j) { const int n = (lane >> 3) + 8 * j; const float* s = scr + (8 * c) * 33 + n;
        v4u o; o.x = pk2(s[0 * 33], s[1 * 33]); o.y = pk2(s[2 * 33], s[3 * 33]); o.z = pk2(s[4 * 33], s[5 * 33]); o.w = pk2(s[6 * 33], s[7 * 33]);
        *(v4u*)(WT + (size_t)(n0 + n) * K + k0 + 8 * c) = o; }
    __builtin_amdgcn_s_waitcnt(0xc07f); asm volatile("" ::: "memory");
}
__device__ __forceinline__ void run_tr(const float* W, int K, int ldw, bf16* WT, int nout, int mode, float* scr, int gw, int NGW, int lane, int& base) {
    const int items = (K / 64) * (nout / 32);
    int it = gw - (base % NGW); if (it < 0) it += NGW;
    for (; it < items; it += NGW) transpose_item(W, K, ldw, WT, nout, mode, scr, it, lane);
    base += items;
}
__device__ __forceinline__ void cvt_rows(const float* src, bf16* dst, size_t n4, int gtid, int NGT) {
    for (size_t i = gtid; i < n4; i += NGT) { const f32x4 v = ((const f32x4*)src)[i]; v2u o; o.x = pk2(v[0], v[1]); o.y = pk2(v[2], v[3]); ((v2u*)dst)[i] = o; }
}

__device__ __forceinline__ void ln_rows(const float* V, const float* g, const float* b, bf16* xb, float* outf, int gw, int NGW, int lane) {
    f32x4 gv[4], bv[4];
#pragma unroll
    for (int j = 0; j < 4; ++j) { gv[j] = ((const f32x4*)g)[lane + 64 * j]; bv[j] = ((const f32x4*)b)[lane + 64 * j]; }
    for (int m = gw; m < T; m += NGW) {
        const f32x4* xr = (const f32x4*)(V + (size_t)m * D) + lane;
        f32x4 v[4]; float s = 0.f;
#pragma unroll
        for (int j = 0; j < 4; ++j) { v[j] = xr[64 * j]; s += (v[j][0] + v[j][1]) + (v[j][2] + v[j][3]); }
        const float mean = wave_sum(s) * (1.f / D); float s2 = 0.f;
#pragma unroll
        for (int j = 0; j < 4; ++j) { v[j] = v[j] - mean; s2 += (v[j][0] * v[j][0] + v[j][1] * v[j][1]) + (v[j][2] * v[j][2] + v[j][3] * v[j][3]); }
        const float rstd = 1.f / sqrtf(wave_sum(s2) * (1.f / D) + LN_EPS);
#pragma unroll
        for (int j = 0; j < 4; ++j) {
            const f32x4 o = v[j] * rstd * gv[j] + bv[j];
            if (xb) { v2u w; w.x = pk2(o[0], o[1]); w.y = pk2(o[2], o[3]); ((v2u*)(xb + (size_t)m * D))[lane + 64 * j] = w; }
            if (outf) ((f32x4*)(outf + (size_t)m * D))[lane + 64 * j] = o;
        }
    }
}

__device__ __forceinline__ void ssd_scan_naive(const Args& a, unsigned char* lds_raw, int unit) {
    const int tid = threadIdx.x, lane = tid & 63;
    const int b = unit >> 6, h = (unit >> 2) & 15, pq = unit & 3, g = h >> 2;
    const bf16* XBC = (const bf16*)(a.ws + WS_XBC); const float* DT = (const float*)((unsigned char*)a.out + DO_DT);
    bf16* YB = (bf16*)((unsigned char*)a.out + DO_YB);
    const float* convw = a.in[I_CONVW]; const float* convb = a.in[I_CONVB];
    const float A = -__expf(a.in[I_ALOG][h]), Dsk = a.in[I_DSKIP][h];
    float* sx = (float*)lds_raw;
    float* sB = sx + 64 * 16;
    float* sC = sB + 64 * 128;
    float* sdt = sC + 64 * 128;
    float* sy = sdt + 64;
    const int p = tid >> 5, nl = tid & 31;
    float hs0 = 0.f, hs1 = 0.f, hs2 = 0.f, hs3 = 0.f;
    for (int t0 = 0; t0 < SEQ; t0 += 64) {
        __syncthreads();
        for (int e = tid; e < 64 * 272; e += NTHR) {
            const int row = e / 272, cc = e % 272;
            const int col = cc < 16 ? (h * 64 + pq * 16 + cc) : (cc < 144 ? (1024 + g * 128 + (cc - 16)) : (1536 + g * 128 + (cc - 144)));
            const int t = t0 + row;
            float accv = convb[col];
#pragma unroll
            for (int k = 0; k < 4; ++k) { const int tt = t - 3 + k; if (tt >= 0) accv += convw[k * 2048 + col] * bf2f(XBC[((size_t)(b * SEQ + tt)) * 2048 + col]); }
            const float v = accv / (1.f + __expf(-accv));
            if (cc < 16) sx[row * 16 + cc] = v; else if (cc < 144) sB[row * 128 + (cc - 16)] = v; else sC[row * 128 + (cc - 144)] = v;
        }
        if (tid < 64) sdt[tid] = DT[(size_t)(b * SEQ + t0 + tid) * 16 + h];
        __syncthreads();
        for (int l = 0; l < 64; ++l) {
            const float dtv = sdt[l], dec = __expf(dtv * A), xr = sx[l * 16 + p], xv = xr * dtv;
            const f32x4 Bv = *(const f32x4*)(sB + l * 128 + nl * 4), Cv = *(const f32x4*)(sC + l * 128 + nl * 4);
            hs0 = hs0 * dec + xv * Bv[0]; hs1 = hs1 * dec + xv * Bv[1]; hs2 = hs2 * dec + xv * Bv[2]; hs3 = hs3 * dec + xv * Bv[3];
            float part = (hs0 * Cv[0] + hs1 * Cv[1]) + (hs2 * Cv[2] + hs3 * Cv[3]);
#pragma unroll
            for (int o = 1; o < 32; o <<= 1) part += __shfl_xor(part, o);
            if (nl == 0) sy[l * 16 + p] = part + Dsk * xr;
        }
        __syncthreads();
        for (int e = tid; e < 64 * 16; e += NTHR) { const int row = e >> 4, cc = e & 15; YB[(size_t)(b * SEQ + t0 + row) * 1024 + h * 64 + pq * 16 + cc] = (bf16)f2bf(sy[e]); }
    }
    (void)lane;
}
__device__ __forceinline__ void ssd_gate_norm(const Args& a, int gw, int NGW, int lane) {
    const bf16* YB = (const bf16*)((unsigned char*)a.out + DO_YB); bf16* ZS = (bf16*)(a.ws + WS_Z); const float* nw = a.in[I_SSDNW];
    for (int m = gw; m < T; m += NGW) {
#pragma unroll
        for (int g = 0; g < 4; ++g) {
            const size_t off = (size_t)m * 1024 + g * 256 + lane * 4;
            const v2u yw = *(const v2u*)(YB + off), zw = *(const v2u*)(ZS + off);
            float v[4] = {bflo(yw.x) * bflo(zw.x), bfhi(yw.x) * bfhi(zw.x), bflo(yw.y) * bflo(zw.y), bfhi(yw.y) * bfhi(zw.y)};
            const float ss = wave_sum((v[0] * v[0] + v[1] * v[1]) + (v[2] * v[2] + v[3] * v[3]));
            const float rs = 1.f / sqrtf(ss * (1.f / 256.f) + RMS_EPS);
            const f32x4 w = *(const f32x4*)(nw + g * 256 + lane * 4);
            v2u o; o.x = pk2(v[0] * rs * w[0], v[1] * rs * w[1]); o.y = pk2(v[2] * rs * w[2], v[3] * rs * w[3]);
            *(v2u*)(ZS + off) = o;
        }
    }
}
__device__ __forceinline__ void ckv_norm(const Args& a, int gw, int NGW, int lane) {
    const float* CKV = (const float*)((unsigned char*)a.out + DO_CKV); bf16* CKVN = (bf16*)(a.ws + WS_CKVN); const float* nw = a.in[I_KVNW];
    const f32x4 w = *(const f32x4*)(nw + lane * 4);
    for (int m = gw; m < T; m += NGW) {
        const f32x4 v = *(const f32x4*)(CKV + (size_t)m * 256 + lane * 4);
        const float ss = wave_sum((v[0] * v[0] + v[1] * v[1]) + (v[2] * v[2] + v[3] * v[3]));
        const float rs = 1.f / sqrtf(ss * (1.f / 256.f) + RMS_EPS);
        v2u o; o.x = pk2(v[0] * rs * w[0], v[1] * rs * w[1]); o.y = pk2(v[2] * rs * w[2], v[3] * rs * w[3]);
        *(v2u*)(CKVN + (size_t)m * 256 + lane * 4) = o;
    }
}

__device__ __forceinline__ unsigned f2sortable(float f) { const unsigned u = __float_as_uint(f); return (u & 0x80000000u) ? ~u : (u | 0x80000000u); }
__device__ __forceinline__ void indexer_topk_naive(const Args& a, unsigned char* lds_raw, int q) {
    const int tid = threadIdx.x, lane = tid & 63, wave = tid >> 6;
    const int b = q / SEQ, t = q % SEQ;
    const bf16* QI = (const bf16*)(a.ws + WS_QI); const bf16* KIDX = (const bf16*)(a.ws + WS_KIDX); const float* WIDX = (const float*)((unsigned char*)a.out + DO_WIDX);
    unsigned short* IDX = (unsigned short*)((unsigned char*)a.out + DO_IDX) + (size_t)q * 256;
    float* sq = (float*)lds_raw;
    float* sw = sq + 1024;
    unsigned* ssc = (unsigned*)(sw + 16);
    unsigned* wcnt = ssc + 4096;
    unsigned* misc = wcnt + 16;
    __syncthreads();
    if (t < 256) { if (tid < 256) IDX[tid] = tid <= t ? (unsigned short)tid : (unsigned short)0xFFFF; return; }
    for (int e = tid; e < 1024; e += NTHR) sq[e] = bf2f(QI[(size_t)q * 1024 + e]);
    if (tid < 16) sw[tid] = WIDX[(size_t)q * 16 + tid];
    if (tid == 0) { misc[0] = 0u; }
    __syncthreads();
    const int nvalid = t + 1;
#pragma unroll 1
    for (int jj = 0; jj < 8; ++jj) {
        const int s = tid + NTHR * jj;
        unsigned u = 0u;
        if (s < nvalid) {
            float kf[64];
            const v4u* kp = (const v4u*)(KIDX + (size_t)(b * SEQ + s) * 64);
#pragma unroll
            for (int c = 0; c < 8; ++c) { const v4u w = kp[c]; kf[8 * c] = bflo(w.x); kf[8 * c + 1] = bfhi(w.x); kf[8 * c + 2] = bflo(w.y); kf[8 * c + 3] = bfhi(w.y); kf[8 * c + 4] = bflo(w.z); kf[8 * c + 5] = bfhi(w.z); kf[8 * c + 6] = bflo(w.w); kf[8 * c + 7] = bfhi(w.w); }
            float sc = 0.f;
#pragma unroll 1
            for (int hh = 0; hh < 16; ++hh) {
                float d0 = 0.f, d1 = 0.f;
#pragma unroll
                for (int d = 0; d < 64; d += 4) { const f32x4 qv = *(const f32x4*)(sq + hh * 64 + d); d0 += qv[0] * kf[d] + qv[2] * kf[d + 2]; d1 += qv[1] * kf[d + 1] + qv[3] * kf[d + 3]; }
                sc += sw[hh] * fmaxf(d0 + d1, 0.f);
            }
            u = f2sortable(sc);
        }
        ssc[s] = u;
    }
    __syncthreads();
    unsigned tau = 0u;
    for (int bit = 31; bit >= 0; --bit) {
        const unsigned cand = tau | (1u << bit);
        unsigned c = 0;
#pragma unroll
        for (int jj = 0; jj < 8; ++jj) c += (unsigned)__popcll(__ballot(ssc[tid + NTHR * jj] >= cand));
        unsigned* wc_ = wcnt + (bit & 1) * 8;
        if (lane == 0) wc_[wave] = c;
        __syncthreads();
        unsigned tot = 0;
#pragma unroll
        for (int w = 0; w < 8; ++w) tot += wc_[w];
        if (tot >= 256u) tau = cand;
    }
    unsigned cgt = 0;
    {
        unsigned c = 0;
#pragma unroll
        for (int jj = 0; jj < 8; ++jj) c += (unsigned)__popcll(__ballot(ssc[tid + NTHR * jj] > tau));
        __syncthreads();
        if (lane == 0) wcnt[wave] = c;
        __syncthreads();
#pragma unroll
        for (int w = 0; w < 8; ++w) cgt += wcnt[w];
    }
    const unsigned need_eq = 256u - cgt;
    unsigned gt_run = 0, eq_run = 0;
    for (int jj = 0; jj < 8; ++jj) {
        const int s = tid + NTHR * jj; const unsigned u = ssc[s];
        const bool gt = (u > tau), eq = (u == tau);
        const unsigned long long bg = __ballot(gt), be = __ballot(eq), lm = (1ull << lane) - 1ull;
        const unsigned ing = (unsigned)__popcll(bg & lm), ine = (unsigned)__popcll(be & lm);
        __syncthreads();
        if (lane == 0) wcnt[wave] = (unsigned)__popcll(bg) | ((unsigned)__popcll(be) << 16);
        __syncthreads();
        unsigned bgt = gt_run, beq = eq_run, allg = 0, alle = 0;
#pragma unroll
        for (int w = 0; w < 8; ++w) { const unsigned cw = wcnt[w]; if (w < wave) { bgt += cw & 0xffffu; beq += cw >> 16; } allg += cw & 0xffffu; alle += cw >> 16; }
        if (gt) IDX[bgt + ing] = (unsigned short)s;
        if (eq) { const unsigned r = beq + ine; if (r < need_eq) IDX[cgt + r] = (unsigned short)s; }
        gt_run += allg; eq_run += alle;
    }
}

__device__ __forceinline__ void sparse_attn_naive(const Args& a, unsigned char* lds_raw, int q) {
    const int tid = threadIdx.x, lane = tid & 63, wave = tid >> 6;
    const int b = q / SEQ, t = q % SEQ;
    bf16* Qb = (bf16*)(a.ws + WS_Q); const bf16* CKVN = (const bf16*)(a.ws + WS_CKVN);
    const unsigned short* IDX = (const unsigned short*)((unsigned char*)a.out + DO_IDX) + (size_t)q * 256;
    const float* wuk = a.in[I_WUK]; const float* wuv = a.in[I_WUV];
    float* sq = (float*)lds_raw;
    float* sql = sq + 1024;
    float* ss = sql + 4096;
    float* so = ss + 4096;
    int* sidx = (int*)(so + 4096);
    __syncthreads();
    for (int e = tid; e < 1024; e += NTHR) sq[e] = bf2f(Qb[(size_t)q * 1024 + e]);
    if (tid < 256) { const int id = IDX[tid]; sidx[tid] = (id == 0xFFFF || id > t) ? -1 : id; }
    __syncthreads();
    {
        const int h = tid >> 5, r8 = (tid & 31) * 8;
        float acc[8] = {0.f, 0.f, 0.f, 0.f, 0.f, 0.f, 0.f, 0.f};
#pragma unroll 2
        for (int d = 0; d < 64; ++d) {
            const float qd = sq[h * 64 + d]; const float* wp = wuk + ((size_t)(h * 64 + d)) * 256 + r8;
            const f32x4 w0 = *(const f32x4*)wp, w1 = *(const f32x4*)(wp + 4);
#pragma unroll
            for (int i = 0; i < 4; ++i) { acc[i] += qd * w0[i]; acc[4 + i] += qd * w1[i]; }
        }
#pragma unroll
        for (int i = 0; i < 8; ++i) sql[h * 256 + r8 + i] = acc[i] * 0.125f;
    }
    __syncthreads();
    {
        const int k = tid >> 1, hh = tid & 1, id = sidx[k];
        float acc[8] = {0.f, 0.f, 0.f, 0.f, 0.f, 0.f, 0.f, 0.f};
        if (id >= 0) {
            const v4u* cp = (const v4u*)(CKVN + (size_t)(b * SEQ + id) * 256);
#pragma unroll 1
            for (int r0 = 0; r0 < 256; r0 += 8) {
                const v4u w = cp[r0 >> 3];
                const float c[8] = {bflo(w.x), bfhi(w.x), bflo(w.y), bfhi(w.y), bflo(w.z), bfhi(w.z), bflo(w.w), bfhi(w.w)};
#pragma unroll
                for (int hl = 0; hl < 8; ++hl) {
                    const float* qp = sql + (hh * 8 + hl) * 256 + r0;
                    const f32x4 q0 = *(const f32x4*)qp, q1 = *(const f32x4*)(qp + 4);
                    acc[hl] += (q0[0] * c[0] + q0[1] * c[1]) + (q0[2] * c[2] + q0[3] * c[3]) + (q1[0] * c[4] + q1[1] * c[5]) + (q1[2] * c[6] + q1[3] * c[7]);
                }
            }
        }
#pragma unroll
        for (int hl = 0; hl < 8; ++hl) {
            const int h = hh * 8 + hl; const float slope = exp2f(-0.5f * (float)(h + 1));
            ss[h * 256 + k] = id >= 0 ? acc[hl] - slope * (float)(t - id) : -INFINITY;
        }
    }
    __syncthreads();
    {
#pragma unroll
        for (int hl = 0; hl < 2; ++hl) {
            float* row = ss + (wave * 2 + hl) * 256;
            float v[4]; float mx = -INFINITY;
#pragma unroll
            for (int i = 0; i < 4; ++i) { v[i] = row[lane + 64 * i]; mx = fmaxf(mx, v[i]); }
            mx = wave_max(mx);
            float sum = 0.f;
#pragma unroll
            for (int i = 0; i < 4; ++i) { v[i] = __expf(v[i] - mx); sum += v[i]; }
            sum = wave_sum(sum);
            const float inv = 1.f / sum;
#pragma unroll
            for (int i = 0; i < 4; ++i) row[lane + 64 * i] = v[i] * inv;
        }
    }
    __syncthreads();
    {
        const int r = tid & 255, hh = tid >> 8;
        float acc[8] = {0.f, 0.f, 0.f, 0.f, 0.f, 0.f, 0.f, 0.f};
#pragma unroll 2
        for (int k = 0; k < 256; ++k) {
            const int id = sidx[k]; if (id < 0) continue;
            const float c = bf2f(CKVN[(size_t)(b * SEQ + id) * 256 + r]);
#pragma unroll
            for (int hl = 0; hl < 8; ++hl) acc[hl] += ss[(hh * 8 + hl) * 256 + k] * c;
        }
#pragma unroll
        for (int hl = 0; hl < 8; ++hl) so[(hh * 8 + hl) * 256 + r] = acc[hl];
    }
    __syncthreads();
    {
        const int h = tid >> 5, d2 = (tid & 31) * 2;
        float a0 = 0.f, a1 = 0.f;
#pragma unroll 4
        for (int r = 0; r < 256; ++r) { const float o = so[h * 256 + r]; const f32x2 w = *(const f32x2*)(wuv + ((size_t)(h * 256 + r)) * 64 + d2); a0 += o * w[0]; a1 += o * w[1]; }
        *(unsigned*)(Qb + (size_t)q * 1024 + h * 64 + d2) = pk2(a0, a1);
    }
}

__device__ __forceinline__ void mem_attn_naive(const Args& a, unsigned char* lds_raw, int q) {
    const int tid = threadIdx.x, lane = tid & 63, wave = tid >> 6;
    const int b = q / SEQ;
    bf16* QM = (bf16*)(a.ws + WS_Z); const bf16* KVM = (const bf16*)(a.ws + WS_KVM);
    float* sq = (float*)lds_raw;
    float* ss = sq + 1024;
    __syncthreads();
    for (int e = tid; e < 1024; e += NTHR) sq[e] = bf2f(QM[(size_t)q * 1024 + e]);
    __syncthreads();
    {
        const int m = tid & 255, hp = tid >> 8;
#pragma unroll
        for (int hl = 0; hl < 2; ++hl) {
            const int hd = hp * 2 + hl;
            const v4u* kp = (const v4u*)(KVM + (size_t)(b * MEML + m) * 2048 + hd * 256);
            float acc = 0.f;
            for (int c = 0; c < 32; ++c) {
                const v4u w = kp[c]; const float* qp = sq + hd * 256 + c * 8;
                const f32x4 q0 = *(const f32x4*)qp, q1 = *(const f32x4*)(qp + 4);
                acc += (q0[0] * bflo(w.x) + q0[1] * bfhi(w.x)) + (q0[2] * bflo(w.y) + q0[3] * bfhi(w.y)) + (q1[0] * bflo(w.z) + q1[1] * bfhi(w.z)) + (q1[2] * bflo(w.w) + q1[3] * bfhi(w.w));
            }
            ss[hd * 256 + m] = acc * 0.0625f;
        }
    }
    __syncthreads();
    if (wave < 4) {
        float* row = ss + wave * 256;
        float v[4]; float mx = -INFINITY;
#pragma unroll
        for (int i = 0; i < 4; ++i) { v[i] = row[lane + 64 * i]; mx = fmaxf(mx, v[i]); }
        mx = wave_max(mx);
        float sum = 0.f;
#pragma unroll
        for (int i = 0; i < 4; ++i) { v[i] = __expf(v[i] - mx); sum += v[i]; }
        sum = wave_sum(sum);
        const float inv = 1.f / sum;
#pragma unroll
        for (int i = 0; i < 4; ++i) row[lane + 64 * i] = v[i] * inv;
    }
    __syncthreads();
    {
        const int c = tid * 2, hd = c >> 8;
        float a0 = 0.f, a1 = 0.f;
        for (int m = 0; m < 256; ++m) { const float p = ss[hd * 256 + m]; const unsigned w = *(const unsigned*)(KVM + (size_t)(b * MEML + m) * 2048 + 1024 + c); a0 += p * bflo(w); a1 += p * bfhi(w); }
        *(unsigned*)(QM + (size_t)q * 1024 + c) = pk2(a0, a1);
    }
}

enum { PH_PREP = 0, PH_FFN1_IN, PH_FFN1_OUT, PH_LN1, PH_INPROJ, PH_SSD_SCAN, PH_SSD_NORM, PH_INDEXER, PH_ATTN, PH_MERGE, PH_WOUT, PH_LN2, PH_QM, PH_MEMATTN, PH_WMO, PH_LN3,
       PH_FFN2_IN, PH_FFN2_OUT, PH_LN4, N_PHASES };

template <class Epi> __device__ __forceinline__ void run_gemm(LAS unsigned char* lds, const bf16* A, const bf16* Bt, int M, int N, int K, const Epi& E) {
    pg8::Gemm g{A, Bt, M, N, K}; pg8::StaticOrder S; S.init(M, N, (int)gridDim.x, (int)blockIdx.x);
    pg8::gemm_phase<Epi, pg8::StaticOrder, true, true>(lds, g, S, E);
}

template <int ph> __device__ __forceinline__ void run_phase(const Args& a, unsigned char* lds) {
    LAS unsigned char* ldsl = (LAS unsigned char*)lds;
    const int tid = threadIdx.x, lane = tid & 63, wave = __builtin_amdgcn_readfirstlane(tid >> 6);
    const int G = gridDim.x, bx = blockIdx.x;
    const int gw = bx * NWAVES + wave, NGW = G * NWAVES, gtid = bx * NTHR + tid, NGT = G * NTHR;
    unsigned char* ws = a.ws; unsigned char* dob = (unsigned char*)a.out;
    bf16* XB = (bf16*)(ws + WS_XB);
    {
        switch (ph) {
        case PH_PREP: {
            float* scr = (float*)(lds + wave * 16384);
            int base = 0;
            run_tr(a.in[I_F1IN], 1024, 2 * DFF, (bf16*)(ws + WS_WA_IN), 2 * DFF, 1, scr, gw, NGW, lane, base);
            run_tr(a.in[I_F1OUT], DFF, 1024, (bf16*)(ws + WS_WA_OUT), 1024, 0, scr, gw, NGW, lane, base);
            run_tr(a.in[I_WIN], 1024, WIN_LD, (bf16*)(ws + WS_WIN), NIN, 2, scr, gw, NGW, lane, base);
            run_tr(a.in[I_WIN], 1024, WIN_LD, (bf16*)(ws + WS_WGS), 1024, 3, scr, gw, NGW, lane, base);
            run_tr(a.in[I_WIN], 1024, WIN_LD, (bf16*)(ws + WS_WGA), 1024, 4, scr, gw, NGW, lane, base);
            run_tr(a.in[I_WPS], 1024, 1024, (bf16*)(ws + WS_WPS), 1024, 0, scr, gw, NGW, lane, base);
            run_tr(a.in[I_WPA], 1024, 1024, (bf16*)(ws + WS_WPA), 1024, 0, scr, gw, NGW, lane, base);
            run_tr(a.in[I_WOUT], 1024, 1024, (bf16*)(ws + WS_WOUT), 1024, 0, scr, gw, NGW, lane, base);
            run_tr(a.in[I_WMQ], 1024, 1024, (bf16*)(ws + WS_WMQ), 1024, 0, scr, gw, NGW, lane, base);
            run_tr(a.in[I_WMO], 1024, 1024, (bf16*)(ws + WS_WMO), 1024, 0, scr, gw, NGW, lane, base);
            run_tr(a.in[I_WMKV], 1024, 2048, (bf16*)(ws + WS_WMKV), 2048, 0, scr, gw, NGW, lane, base);
            cvt_rows(a.in[I_X], XB, (size_t)T * D / 4, gtid, NGT);
            cvt_rows(a.in[I_MEM], (bf16*)(ws + WS_MEMB), (size_t)BATCH * MEML * D / 4, gtid, NGT);
        } break;
        case PH_FFN1_IN: {
            pg8::EpiSwiglu E{(bf16*)(ws + WS_H), DFF};
            run_gemm(ldsl, XB, (const bf16*)(ws + WS_WA_IN), T, 2 * DFF, D, E);
            pg8::EpiPlain E2{(bf16*)(ws + WS_KVM), 2048};
            run_gemm(ldsl, (const bf16*)(ws + WS_MEMB), (const bf16*)(ws + WS_WMKV), BATCH * MEML, 2048, D, E2);
        } break;
        case PH_FFN1_OUT: {
            pg8::EpiRes<false> E{a.in[I_X], (float*)dob, ALPHA, 0.5f};
            run_gemm(ldsl, (const bf16*)(ws + WS_H), (const bf16*)(ws + WS_WA_OUT), T, D, DFF, E);
        } break;
        case PH_LN1: ln_rows((const float*)dob, a.in[I_LN1G], a.in[I_LN1B], XB, nullptr, gw, NGW, lane); break;
        case PH_INPROJ: {
            pg8::EpiInproj E{(bf16*)(ws + WS_Z), (bf16*)(ws + WS_XBC), (bf16*)(ws + WS_Q), (bf16*)(ws + WS_QI), (bf16*)(ws + WS_KIDX),
                             (float*)(dob + DO_CKV), (float*)(dob + DO_DT), (float*)(dob + DO_WIDX), a.in[I_DTB]};
            run_gemm(ldsl, XB, (const bf16*)(ws + WS_WIN), T, NIN, D, E);
            __syncthreads();
            float* scr = (float*)(lds + wave * 16384);
            int base = 0;
            run_tr(a.in[I_F2IN], 1024, 2 * DFF, (bf16*)(ws + WS_WA_IN), 2 * DFF, 1, scr, gw, NGW, lane, base);
            run_tr(a.in[I_F2OUT], DFF, 1024, (bf16*)(ws + WS_WA_OUT), 1024, 0, scr, gw, NGW, lane, base);
        } break;
        case PH_SSD_SCAN: {
            for (int u = bx; u < 256; u += G) ssd_scan_naive(a, lds, u);
            ckv_norm(a, gw, NGW, lane);
        } break;
        case PH_SSD_NORM: ssd_gate_norm(a, gw, NGW, lane); break;
        case PH_INDEXER: for (int q = bx; q < T; q += G) indexer_topk_naive(a, lds, q); break;
        case PH_ATTN: for (int q = bx; q < T; q += G) sparse_attn_naive(a, lds, q); break;
        case PH_MERGE: {
            bf16* Sg1 = (bf16*)(ws + WS_QI); bf16* Sg2 = (bf16*)(dob + DO_SG2); float* Sm = (float*)(ws + WS_XBC); bf16* MG = (bf16*)(dob + DO_MERGED);
            { pg8::EpiMerge<0> E{Sg1, Sm, MG}; run_gemm(ldsl, XB, (const bf16*)(ws + WS_WGS), T, D, D, E); }
            { pg8::EpiMerge<1> E{Sg1, Sm, MG}; run_gemm(ldsl, (const bf16*)(ws + WS_Z), (const bf16*)(ws + WS_WPS), T, D, D, E); }
            { pg8::EpiMerge<0> E{Sg2, Sm, MG}; run_gemm(ldsl, XB, (const bf16*)(ws + WS_WGA), T, D, D, E); }
            { pg8::EpiMerge<2> E{Sg2, Sm, MG}; run_gemm(ldsl, (const bf16*)(ws + WS_Q), (const bf16*)(ws + WS_WPA), T, D, D, E); }
        } break;
        case PH_WOUT: {
            pg8::EpiRes<true> E{XB, (float*)(ws + WS_XBC), ALPHA, 1.0f};
            run_gemm(ldsl, (const bf16*)(dob + DO_MERGED), (const bf16*)(ws + WS_WOUT), T, D, D, E);
        } break;
        case PH_LN2: ln_rows((const float*)(ws + WS_XBC), a.in[I_LN2G], a.in[I_LN2B], XB, nullptr, gw, NGW, lane); break;
        case PH_QM: {
            pg8::EpiPlain E{(bf16*)(ws + WS_Z), 1024};
            run_gemm(ldsl, XB, (const bf16*)(ws + WS_WMQ), T, D, D, E);
        } break;
        case PH_MEMATTN: for (int q = bx; q < T; q += G) mem_attn_naive(a, lds, q); break;
        case PH_WMO: {
            pg8::EpiRes<true> E{XB, (float*)dob, ALPHA, 1.0f};
            run_gemm(ldsl, (const bf16*)(ws + WS_Z), (const bf16*)(ws + WS_WMO), T, D, D, E);
        } break;
        case PH_LN3: ln_rows((const float*)dob, a.in[I_LN3G], a.in[I_LN3B], XB, nullptr, gw, NGW, lane); break;
        case PH_FFN2_IN: {
            pg8::EpiSwiglu E{(bf16*)(ws + WS_H), DFF};
            run_gemm(ldsl, XB, (const bf16*)(ws + WS_WA_IN), T, 2 * DFF, D, E);
        } break;
        case PH_FFN2_OUT: {
            pg8::EpiRes<true> E{XB, (float*)dob, ALPHA, 0.5f};
            run_gemm(ldsl, (const bf16*)(ws + WS_H), (const bf16*)(ws + WS_WA_OUT), T, D, DFF, E);
        } break;
        case PH_LN4: ln_rows((const float*)dob, a.in[I_LN4G], a.in[I_LN4B], nullptr, (float*)dob, gw, NGW, lane); break;
        default: break;
        }
    }
}

template <int PH> __global__ void __launch_bounds__(NTHR, 2) k_phase(Args a) {
    extern __shared__ __attribute__((aligned(16))) unsigned char lds[];
    run_phase<PH>(a, lds);
}
template <int PH> static void launch_phase(const Args& a, int grid, hipStream_t stream) {
    static bool attr = false;
    if (!attr) { (void)hipFuncSetAttribute((const void*)k_phase<PH>, hipFuncAttributeMaxDynamicSharedMemorySize, LDS_BYTES); attr = true; }
    hipLaunchKernelGGL(k_phase<PH>, dim3(grid), dim3(NTHR), LDS_BYTES, stream, a);
}
template <int PH> static void launch_all(const Args& a, int grid, hipStream_t stream) {
    if constexpr (PH < N_PHASES) { launch_phase<PH>(a, grid, stream); launch_all<PH + 1>(a, grid, stream); }
}

#ifndef CUT_PHASE
#define CUT_PHASE -1
#endif
#ifndef CUT_SRC
#define CUT_SRC WS_XB
#endif
__global__ void __launch_bounds__(NTHR) k_dump(Args a) {
    const bf16* src = (const bf16*)(a.ws + CUT_SRC);
    const size_t n = (size_t)T * D;
    for (size_t i = (size_t)blockIdx.x * NTHR + threadIdx.x; i < n; i += (size_t)gridDim.x * NTHR) a.out[i] = bf2f(src[i]);
}
template <int PH> static void launch_upto(const Args& a, int grid, hipStream_t stream) {
    if constexpr (PH < N_PHASES) { if (PH <= CUT_PHASE) { launch_phase<PH>(a, grid, stream); launch_upto<PH + 1>(a, grid, stream); } }
}

extern "C" void kernel_launch(void* const* d_in, const int* in_sizes, int n_in, void* d_out, int out_size, void* d_ws, size_t ws_size, hipStream_t stream) {
    static int grid = 0;
    if (grid == 0) {
        if (n_in != 30 || out_size != T * D || ws_size < WS_END) { fprintf(stderr, "kernel_launch: unexpected shapes n_in %d out %d ws %zu\n", n_in, out_size, ws_size); grid = -1; return; }
        grid = 256;
    }
    if (grid < 0) return;
    Args a{};
    for (int i = 0; i < 30; ++i) a.in[i] = (const float*)d_in[i];
    a.out = (float*)d_out; a.ws = (unsigned char*)d_ws;
    a.ph_lo = 0; a.ph_hi = N_PHASES;
    if (CUT_PHASE < 0) launch_all<0>(a, grid, stream);
    else { launch_upto<0>(a, grid, stream); hipLaunchKernelGGL(k_dump, dim3(1024), dim3(NTHR), 0, stream, a); }
}
```

```cpp
#include <hip/hip_runtime.h>
#include <hip/hip_cooperative_groups.h>
#include <cstdio>
#include <cstdint>
namespace pg8 {
#define PG8_LAS __attribute__((address_space(3)))
typedef unsigned short bf16_t;
typedef short bf16x8 __attribute__((ext_vector_type(8)));
typedef float f32x4 __attribute__((ext_vector_type(4)));
typedef unsigned u32x4 __attribute__((ext_vector_type(4)));
constexpr int BM = 256, BK = 64, HALF = 128, HTB = HALF * BK * 2  , STAGE_BYTES = 8 * HTB, NXCD = 8, WGM = 8;

__host__ __device__ __forceinline__ int lds_byte(int r, int c) { const int st = (r >> 4) * 2 + (c >> 5), rr = r & 15, cc = c & 31, ob = rr * 64 + cc * 2; return st * 1024 + (ob ^ (((ob >> 9) & 1) << 5)); }
__host__ __device__ __forceinline__ void stage_rc(int b, int& R, int& C) { const int st = b / 1024, sb = b % 1024, swz = sb ^ (((sb >> 9) & 1) << 5); R = (st >> 1) * 16 + swz / 64; C = (st & 1) * 32 + (swz % 64) / 2; }
__host__ __device__ __forceinline__ int perm32(int rho) { const int n = rho >> 4, i = rho & 15; return 8 * (i >> 2) + 4 * n + (i & 3); }

struct Unit { int pm, pn; };
struct Gemm { const bf16_t* A; const bf16_t* Bt; int M, N, K; };

struct StaticOrder {
    int nM, nN, nwg, G, c;
    __host__ __device__ void init(int M, int N, int G_, int c_) { nM = M / BM; nN = N / BM; nwg = nM * nN; G = G_; c = c_; }
    __host__ __device__ bool next(int i, Unit& u) const {
        const long L = (long)i * G + c; if (L >= nwg) return false;
        int wgid = (int)L; { const int q = nwg / NXCD, r = nwg % NXCD, xcd = wgid % NXCD, off = wgid / NXCD; wgid = (xcd < r ? xcd * (q + 1) : r * (q + 1) + (xcd - r) * q) + off; }
        const int nig = WGM * nN, gid = wgid / nig, fm = gid * WGM, gsz = (nM - fm) < WGM ? (nM - fm) : WGM;
        u.pm = fm + ((wgid % nig) % gsz); u.pn = (wgid % nig) / gsz; return true;
    }
    __device__ __forceinline__ void a_ready(const Unit&) const {}
    __device__ __forceinline__ void done(const Unit&) const {}
};

typedef float f32x2 __attribute__((ext_vector_type(2)));
typedef __bf16 bf16x2_t __attribute__((ext_vector_type(2)));
__device__ __forceinline__ unsigned cvt_pk_bf16(float lo, float hi) { f32x2 v = {lo, hi}; bf16x2_t b = __builtin_convertvector(v, bf16x2_t); return __builtin_bit_cast(unsigned, b); }
typedef unsigned u32x2 __attribute__((ext_vector_type(2)));
__device__ __forceinline__ float sigm(float x) { return __builtin_amdgcn_rcpf(1.f + __expf(-x)); }
__device__ __forceinline__ float silu(float x) { return x * sigm(x); }
__device__ __forceinline__ float bf_lo(unsigned w) { return __uint_as_float(w << 16); }
__device__ __forceinline__ float bf_hi(unsigned w) { return __uint_as_float(w & 0xffff0000u); }
__device__ __forceinline__ u32x4 pack8(const float (&h)[8]) { u32x4 w; w.x = cvt_pk_bf16(h[0], h[1]); w.y = cvt_pk_bf16(h[2], h[3]); w.z = cvt_pk_bf16(h[4], h[5]); w.w = cvt_pk_bf16(h[6], h[7]); return w; }
__device__ __forceinline__ void unpack8(u32x4 w, float (&h)[8]) { h[0] = bf_lo(w.x); h[1] = bf_hi(w.x); h[2] = bf_lo(w.y); h[3] = bf_hi(w.y); h[4] = bf_lo(w.z); h[5] = bf_hi(w.z); h[6] = bf_lo(w.w); h[7] = bf_hi(w.w); }

struct EpiSwiglu {
    static constexpr bool PERM = true, AFTER_DRAIN = false;
    bf16_t* O; int ldo;
    __device__ __forceinline__ void operator()(const f32x4 (&acc)[2][2][4][2], const Unit& u, int wr, int wc, int fr, int fq) const {
        const int row0 = u.pm * BM + wr * 64 + fr, col0 = u.pn * 128 + wc * 32 + 8 * fq;
#pragma unroll
        for (int ai = 0; ai < 2; ++ai)
#pragma unroll
            for (int m = 0; m < 4; ++m) {
                float h[8];
#pragma unroll
                for (int n = 0; n < 2; ++n)
#pragma unroll
                    for (int i = 0; i < 4; ++i) h[n * 4 + i] = silu(acc[ai][0][m][n][i]) * acc[ai][1][m][n][i];
                *(u32x4*)(O + (size_t)(row0 + ai * HALF + m * 16) * ldo + col0) = pack8(h);
            }
    }
};
struct EpiPlain {
    static constexpr bool PERM = true, AFTER_DRAIN = false;
    bf16_t* O; int ldo;
    __device__ __forceinline__ void operator()(const f32x4 (&acc)[2][2][4][2], const Unit& u, int wr, int wc, int fr, int fq) const {
        const int row0 = u.pm * BM + wr * 64 + fr, col0 = u.pn * BM + wc * 32 + 8 * fq;
#pragma unroll
        for (int ai = 0; ai < 2; ++ai)
#pragma unroll
            for (int m = 0; m < 4; ++m)
#pragma unroll
                for (int bj = 0; bj < 2; ++bj) {
                    float h[8];
#pragma unroll
                    for (int n = 0; n < 2; ++n)
#pragma unroll
                        for (int i = 0; i < 4; ++i) h[n * 4 + i] = acc[ai][bj][m][n][i];
                    *(u32x4*)(O + (size_t)(row0 + ai * HALF + m * 16) * ldo + col0 + bj * HALF) = pack8(h);
                }
    }
};
template <bool BASE_BF16> struct EpiRes {
    static constexpr bool PERM = true, AFTER_DRAIN = false;
    const void* base; float* V; float alpha, scale;
    __device__ __forceinline__ void operator()(const f32x4 (&acc)[2][2][4][2], const Unit& u, int wr, int wc, int fr, int fq) const {
        const int row0 = u.pm * BM + wr * 64 + fr, col0 = u.pn * BM + wc * 32 + 8 * fq;
#pragma unroll
        for (int ai = 0; ai < 2; ++ai)
#pragma unroll
            for (int m = 0; m < 4; ++m)
#pragma unroll
                for (int bj = 0; bj < 2; ++bj) {
                    const size_t off = (size_t)(row0 + ai * HALF + m * 16) * 1024 + col0 + bj * HALF;
                    float b[8];
                    if (BASE_BF16) { unpack8(*(const u32x4*)((const bf16_t*)base + off), b); }
                    else { const f32x4 b0 = *(const f32x4*)((const float*)base + off), b1 = *(const f32x4*)((const float*)base + off + 4);
                        b[0] = b0[0]; b[1] = b0[1]; b[2] = b0[2]; b[3] = b0[3]; b[4] = b1[0]; b[5] = b1[1]; b[6] = b1[2]; b[7] = b1[3]; }
                    f32x4 v0, v1;
#pragma unroll
                    for (int i = 0; i < 4; ++i) { v0[i] = alpha * b[i] + scale * acc[ai][bj][m][0][i]; v1[i] = alpha * b[4 + i] + scale * acc[ai][bj][m][1][i]; }
                    *(f32x4*)(V + off) = v0; *(f32x4*)(V + off + 4) = v1;
                }
    }
};
struct EpiInproj {
    static constexpr bool PERM = true, AFTER_DRAIN = false;
    bf16_t *ZS, *XBC, *Q, *QI, *KIDX; float *CKV, *DT, *WIDX; const float* dt_bias;
    __device__ __forceinline__ void operator()(const f32x4 (&acc)[2][2][4][2], const Unit& u, int wr, int wc, int fr, int fq) const {
        const int row0 = u.pm * BM + wr * 64 + fr, lc0 = wc * 32 + 8 * fq, pn = u.pn;
#pragma unroll
        for (int ai = 0; ai < 2; ++ai)
#pragma unroll
            for (int m = 0; m < 4; ++m)
#pragma unroll
                for (int bj = 0; bj < 2; ++bj) {
                    const size_t row = (size_t)(row0 + ai * HALF + m * 16); const int lc = lc0 + bj * HALF;
                    float h[8];
#pragma unroll
                    for (int n = 0; n < 2; ++n)
#pragma unroll
                        for (int i = 0; i < 4; ++i) h[n * 4 + i] = acc[ai][bj][m][n][i];
                    if (pn < 4) {
#pragma unroll
                        for (int i = 0; i < 8; ++i) h[i] = silu(h[i]);
                        *(u32x4*)(ZS + row * 1024 + pn * 256 + lc) = pack8(h);
                    } else if (pn < 12) { *(u32x4*)(XBC + row * 2048 + (pn - 4) * 256 + lc) = pack8(h);
                    } else if (pn < 16) { *(u32x4*)(Q + row * 1024 + (pn - 12) * 256 + lc) = pack8(h);
                    } else if (pn < 20) { *(u32x4*)(QI + row * 1024 + (pn - 16) * 256 + lc) = pack8(h);
                    } else if (pn == 20) { *(f32x4*)(CKV + row * 256 + lc) = (f32x4){h[0], h[1], h[2], h[3]}; *(f32x4*)(CKV + row * 256 + lc + 4) = (f32x4){h[4], h[5], h[6], h[7]};
                    } else {
                        if (lc < 64) { *(u32x4*)(KIDX + row * 64 + lc) = pack8(h); }
                        else if (lc < 80) { const int h0 = lc - 64; float d[8];
#pragma unroll
                            for (int i = 0; i < 8; ++i) { const float xx = h[i] + dt_bias[h0 + i]; d[i] = xx > 20.f ? xx : __logf(1.f + __expf(xx)); }
                            *(f32x4*)(DT + row * 16 + h0) = (f32x4){d[0], d[1], d[2], d[3]}; *(f32x4*)(DT + row * 16 + h0 + 4) = (f32x4){d[4], d[5], d[6], d[7]}; }
                        else if (lc < 96) { const int h0 = lc - 80;
                            *(f32x4*)(WIDX + row * 16 + h0) = (f32x4){h[0] * 0.25f, h[1] * 0.25f, h[2] * 0.25f, h[3] * 0.25f}; *(f32x4*)(WIDX + row * 16 + h0 + 4) = (f32x4){h[4] * 0.25f, h[5] * 0.25f, h[6] * 0.25f, h[7] * 0.25f}; }
                    }
                }
    }
};
template <int MODE> struct EpiMerge {
    static constexpr bool PERM = true, AFTER_DRAIN = false;
    bf16_t* G; float* Sm; bf16_t* Out;
    __device__ __forceinline__ void operator()(const f32x4 (&acc)[2][2][4][2], const Unit& u, int wr, int wc, int fr, int fq) const {
        const int row0 = u.pm * BM + wr * 64 + fr, col0 = u.pn * BM + wc * 32 + 8 * fq;
#pragma unroll
        for (int ai = 0; ai < 2; ++ai)
#pragma unroll
            for (int m = 0; m < 4; ++m)
#pragma unroll
                for (int bj = 0; bj < 2; ++bj) {
                    const size_t off = (size_t)(row0 + ai * HALF + m * 16) * 1024 + col0 + bj * HALF;
                    float h[8];
#pragma unroll
                    for (int n = 0; n < 2; ++n)
#pragma unroll
                        for (int i = 0; i < 4; ++i) h[n * 4 + i] = acc[ai][bj][m][n][i];
                    if (MODE == 0) {
#pragma unroll
                        for (int i = 0; i < 8; ++i) h[i] = sigm(h[i]);
                        *(u32x4*)(G + off) = pack8(h);
                    } else if (MODE == 1) { float g[8]; unpack8(*(const u32x4*)(G + off), g);
                        *(f32x4*)(Sm + off) = (f32x4){g[0] * h[0], g[1] * h[1], g[2] * h[2], g[3] * h[3]}; *(f32x4*)(Sm + off + 4) = (f32x4){g[4] * h[4], g[5] * h[5], g[6] * h[6], g[7] * h[7]};
                    } else { float g[8]; unpack8(*(const u32x4*)(G + off), g); const f32x4 s0 = *(const f32x4*)(Sm + off), s1 = *(const f32x4*)(Sm + off + 4);
#pragma unroll
                        for (int i = 0; i < 4; ++i) { h[i] = s0[i] + g[i] * h[i]; h[4 + i] = s1[i] + g[4 + i] * h[4 + i]; }
                        *(u32x4*)(Out + off) = pack8(h); }
                }
    }
};
template <class Epi, class Sched, bool ALIGN_EPI = false, bool SP2 = false>
__device__ __forceinline__ void gemm_phase(PG8_LAS unsigned char* lds, const Gemm g, const Sched& S, const Epi& E) {
    const int tid = threadIdx.x, wid = __builtin_amdgcn_readfirstlane(tid >> 6), lane = tid & 63, wr = wid >> 2, wc = wid & 3, fr = lane & 15, fq = lane >> 4;
    const int K = g.K, nt = K / BK;
    unsigned voffA[2], voffB[2];
#pragma unroll
    for (int i = 0; i < 2; ++i) { int R, C; stage_rc(tid * 16 + i * 8192, R, C); const int Rb = Epi::PERM ? ((R & ~31) + perm32(R & 31)) : R;
        voffA[i] = (unsigned)(R * K + C) * 2u; voffB[i] = (unsigned)(Rb * K + C) * 2u; }
    const size_t kstep = (size_t)(BK * 2);
    const size_t hstep = (size_t)HALF * K * 2;
    const size_t tstep = 2 * hstep;
    const unsigned ldsw = (unsigned)wid * 1024u;
    const int aoff = lds_byte(wr * 64 + fr, fq * 8), boff = lds_byte(wc * 32 + fr, fq * 8);
#define PG8_SA(b, h) (((b) * 2 + (h)) * HTB)
#define PG8_SB(b, h) ((4 + (b) * 2 + (h)) * HTB)
#define PG8_STAGE(bufoff, gbase, voff) do { _Pragma("unroll") for (int _i = 0; _i < 2; ++_i) \
        __builtin_amdgcn_global_load_lds((const unsigned*)((const char*)(gbase) + (voff)[_i]), (PG8_LAS unsigned*)(lds + (bufoff) + ldsw + _i * 8192), 16, 0, 0); } while (0)
#define PG8_LDA(dst, b, h) do { _Pragma("unroll") for (int m = 0; m < 4; ++m) _Pragma("unroll") for (int k = 0; k < 2; ++k) dst[m][k] = *(const PG8_LAS bf16x8*)(lds + PG8_SA(b, h) + aoff + m * 2048 + k * 1024); } while (0)
#define PG8_LDB(dst, b, h) do { _Pragma("unroll") for (int n = 0; n < 2; ++n) _Pragma("unroll") for (int k = 0; k < 2; ++k) dst[n][k] = *(const PG8_LAS bf16x8*)(lds + PG8_SB(b, h) + boff + n * 2048 + k * 1024); } while (0)
#define PG8_MMA(ai, bj, At, Bt) do { __builtin_amdgcn_s_setprio(1); _Pragma("unroll") for (int m = 0; m < 4; ++m) _Pragma("unroll") for (int n = 0; n < 2; ++n) _Pragma("unroll") for (int k = 0; k < 2; ++k) \
        acc[ai][bj][m][n] = __builtin_amdgcn_mfma_f32_16x16x32_bf16(Bt[n][k], At[m][k], acc[ai][bj][m][n], 0, 0, 0); __builtin_amdgcn_s_setprio(0); } while (0)
#define PG8_WAIT_V(n) asm volatile("s_waitcnt vmcnt(" #n ")" ::: "memory")
#define PG8_WAIT_L(n) asm volatile("s_waitcnt lgkmcnt(" #n ")" ::: "memory")
#define PG8_BAR __builtin_amdgcn_s_barrier()
#define PG8_SCHED __builtin_amdgcn_sched_barrier(0)
    Unit cur, nxt; int ui = 0;
    if (!S.next(0, cur)) return;
    f32x4 acc[2][2][4][2];
#pragma unroll
    for (int a = 0; a < 2; ++a)
#pragma unroll
        for (int b = 0; b < 2; ++b)
#pragma unroll
            for (int m = 0; m < 4; ++m)
#pragma unroll
                for (int n = 0; n < 2; ++n) acc[a][b][m][n] = (f32x4){0.f, 0.f, 0.f, 0.f};
    bf16x8 At[4][2], B0[2][2], B1[2][2];
    const char* cA = (const char*)g.A + (size_t)cur.pm * tstep; const char* cB = (const char*)g.Bt + (size_t)cur.pn * tstep;
    S.a_ready(cur);
    if constexpr (SP2) {
        PG8_STAGE(PG8_SB(0, 0), cB, voffB); PG8_STAGE(PG8_SB(0, 1), cB + hstep, voffB); PG8_STAGE(PG8_SA(0, 0), cA, voffA); PG8_STAGE(PG8_SA(0, 1), cA + hstep, voffA);
        if (wr == 1) PG8_BAR;
        PG8_WAIT_V(2); PG8_BAR;
        PG8_STAGE(PG8_SB(1, 0), cB + kstep, voffB); PG8_STAGE(PG8_SA(1, 0), cA + kstep, voffA); PG8_STAGE(PG8_SB(1, 1), cB + hstep + kstep, voffB);
        PG8_WAIT_V(6); PG8_BAR;
    } else {
        PG8_STAGE(PG8_SB(0, 0), cB, voffB); PG8_STAGE(PG8_SA(0, 0), cA, voffA); PG8_STAGE(PG8_SB(0, 1), cB + hstep, voffB); PG8_STAGE(PG8_SA(0, 1), cA + hstep, voffA);
        if (wr == 1) PG8_BAR;
        PG8_WAIT_V(4); PG8_BAR;
        PG8_STAGE(PG8_SB(1, 0), cB + kstep, voffB); PG8_STAGE(PG8_SA(1, 0), cA + kstep, voffA); PG8_STAGE(PG8_SB(1, 1), cB + hstep + kstep, voffB);
        PG8_WAIT_V(6); PG8_BAR;
    }
    for (;;) {
        const bool has_next = S.next(ui + 1, nxt);
        const char* nA = has_next ? (const char*)g.A + (size_t)nxt.pm * tstep : cA; const char* nB = has_next ? (const char*)g.Bt + (size_t)nxt.pn * tstep : cB;
        for (int t = 0; t < nt; t += 2) {
            const bool last = (t == nt - 2);
            const char* a1 = cA + (size_t)(t + 1) * kstep;
            const char* a2 = last ? nA : cA + (size_t)(t + 2) * kstep; const char* b2 = last ? nB : cB + (size_t)(t + 2) * kstep;
            const char* a3 = a2 + kstep; const char* b3 = b2 + kstep;
            if (last && has_next) S.a_ready(nxt);
            if constexpr (SP2) {
            PG8_LDB(B0, 0, 0); PG8_LDB(B1, 0, 1); PG8_SCHED; PG8_LDA(At, 0, 0); PG8_STAGE(PG8_SA(1, 1), a1 + hstep, voffA);
            PG8_WAIT_V(8); PG8_WAIT_L(0); PG8_BAR; PG8_MMA(0, 0, At, B0); PG8_MMA(0, 1, At, B1); PG8_BAR; PG8_SCHED;
            PG8_LDA(At, 0, 1); PG8_STAGE(PG8_SB(0, 0), b2, voffB); PG8_STAGE(PG8_SB(0, 1), b2 + hstep, voffB); PG8_STAGE(PG8_SA(0, 0), a2, voffA);
            PG8_WAIT_V(8); PG8_WAIT_L(0); PG8_BAR; PG8_MMA(1, 0, At, B0); PG8_MMA(1, 1, At, B1); PG8_BAR; PG8_SCHED;
            PG8_LDB(B0, 1, 0); PG8_LDB(B1, 1, 1); PG8_SCHED; PG8_LDA(At, 1, 0); PG8_STAGE(PG8_SA(0, 1), a2 + hstep, voffA);
            PG8_WAIT_V(8); PG8_WAIT_L(0); PG8_BAR; PG8_MMA(0, 0, At, B0); PG8_MMA(0, 1, At, B1); PG8_BAR; PG8_SCHED;
            PG8_LDA(At, 1, 1); PG8_STAGE(PG8_SB(1, 0), b3, voffB); PG8_STAGE(PG8_SB(1, 1), b3 + hstep, voffB); PG8_STAGE(PG8_SA(1, 0), a3, voffA);
            PG8_WAIT_V(8); PG8_WAIT_L(0); PG8_BAR; PG8_MMA(1, 0, At, B0); PG8_MMA(1, 1, At, B1); PG8_BAR; PG8_SCHED;
            } else {
            PG8_LDB(B0, 0, 0); PG8_SCHED; PG8_LDA(At, 0, 0); PG8_STAGE(PG8_SA(1, 1), a1 + hstep, voffA);
            PG8_WAIT_L(8); PG8_BAR; PG8_WAIT_L(0); PG8_MMA(0, 0, At, B0); PG8_BAR; PG8_SCHED;
            PG8_LDB(B1, 0, 1); PG8_STAGE(PG8_SB(0, 0), b2, voffB);
            PG8_BAR; PG8_WAIT_L(0); PG8_MMA(0, 1, At, B1); PG8_BAR;
            PG8_LDA(At, 0, 1); PG8_STAGE(PG8_SA(0, 0), a2, voffA);
            PG8_BAR; PG8_WAIT_L(0); PG8_MMA(1, 0, At, B0); PG8_BAR; PG8_SCHED;
            PG8_STAGE(PG8_SB(0, 1), b2 + hstep, voffB);
            PG8_WAIT_V(6); PG8_BAR; PG8_MMA(1, 1, At, B1); PG8_BAR;
            PG8_LDB(B0, 1, 0); PG8_SCHED; PG8_LDA(At, 1, 0); PG8_STAGE(PG8_SA(0, 1), a2 + hstep, voffA);
            PG8_WAIT_L(8); PG8_BAR; PG8_WAIT_L(0); PG8_MMA(0, 0, At, B0); PG8_BAR; PG8_SCHED;
            PG8_LDB(B1, 1, 1); PG8_STAGE(PG8_SB(1, 0), b3, voffB);
            PG8_BAR; PG8_WAIT_L(0); PG8_MMA(0, 1, At, B1); PG8_BAR;
            PG8_LDA(At, 1, 1); PG8_STAGE(PG8_SA(1, 0), a3, voffA);
            PG8_BAR; PG8_WAIT_L(0); PG8_MMA(1, 0, At, B0); PG8_BAR; PG8_SCHED;
            PG8_STAGE(PG8_SB(1, 1), b3 + hstep, voffB);
            PG8_WAIT_V(6); PG8_BAR; PG8_MMA(1, 1, At, B1); PG8_BAR;
            }
        }
        if constexpr (ALIGN_EPI) { if (wr == 0) PG8_BAR; }
        if constexpr (!Epi::AFTER_DRAIN) { E(acc, cur, wr, wc, fr, fq); S.done(cur); }
        if (!has_next) break;
#pragma unroll
        for (int a = 0; a < 2; ++a)
#pragma unroll
            for (int b = 0; b < 2; ++b)
#pragma unroll
                for (int m = 0; m < 4; ++m)
#pragma unroll
                    for (int n = 0; n < 2; ++n) acc[a][b][m][n] = (f32x4){0.f, 0.f, 0.f, 0.f};
        cur = nxt; cA = nA; cB = nB; ++ui;
        if constexpr (ALIGN_EPI) { if (wr == 1) PG8_BAR; }
    }
    PG8_WAIT_V(0);
    if constexpr (!ALIGN_EPI) { if (wr == 0) PG8_BAR; }
    PG8_BAR;
    if constexpr (Epi::AFTER_DRAIN) { E.fused(acc, cur, wr, wc, fr, fq, lds, wid, lane); S.done(cur); }
#undef PG8_SA
#undef PG8_SB
#undef PG8_STAGE
#undef PG8_LDA
#undef PG8_LDB
#undef PG8_MMA
#undef PG8_WAIT_V
#undef PG8_WAIT_L
#undef PG8_BAR
#undef PG8_SCHED
}
}

#define LAS __attribute__((address_space(3)))
typedef unsigned short bf16;
typedef unsigned v4u __attribute__((ext_vector_type(4)));
typedef unsigned v2u __attribute__((ext_vector_type(2)));
typedef float f32x4 __attribute__((ext_vector_type(4)));
typedef float f32x2 __attribute__((ext_vector_type(2)));
constexpr int NWAVES = 8, NTHR = 512;
constexpr int BATCH = 4, SEQ = 4096, D = 1024, T = BATCH * SEQ, DFF = 2816, MEML = 256;
constexpr int NIN = 5632;
constexpr int WIN_LD = 7520;
constexpr float ALPHA = 1.189207115002721f;
constexpr float LN_EPS = 1e-5f, RMS_EPS = 1e-6f;
constexpr size_t MiB = 1u << 20;
constexpr size_t WS_CTL = 0;
constexpr size_t WS_WA_IN = 1 * MiB, WS_WA_OUT = 12 * MiB;
constexpr size_t WS_WIN = 18 * MiB;
constexpr size_t WS_WGS = 29 * MiB, WS_WGA = 31 * MiB, WS_WPS = 33 * MiB, WS_WPA = 35 * MiB, WS_WOUT = 37 * MiB, WS_WMQ = 39 * MiB, WS_WMO = 41 * MiB, WS_WMKV = 43 * MiB;
constexpr size_t WS_MEMB = 47 * MiB, WS_KVM = 49 * MiB;
constexpr size_t WS_WUK = 53 * MiB;
constexpr size_t WS_XB = 54 * MiB;
constexpr size_t WS_Z = 86 * MiB;
constexpr size_t WS_Q = 118 * MiB;
constexpr size_t WS_XBC = 150 * MiB;
constexpr size_t WS_QI = 214 * MiB;
constexpr size_t WS_CKVN = 246 * MiB;
constexpr size_t WS_KIDX = 254 * MiB;
constexpr size_t WS_H = 86 * MiB;
constexpr size_t WS_END = 256 * MiB;
constexpr size_t DO_CKV = 0, DO_DT = 16 * MiB, DO_WIDX = 17 * MiB, DO_IDX = 18 * MiB, DO_YB = 26 * MiB;
constexpr size_t DO_SG2 = 0, DO_MERGED = 32 * MiB;
constexpr int LDS_BYTES = 147456;

__device__ __forceinline__ unsigned f2bf(float f) { unsigned u = __builtin_bit_cast(unsigned, f); return (u + 0x7fffu + ((u >> 16) & 1u)) >> 16; }
__device__ __forceinline__ unsigned pk2(float lo, float hi) { return f2bf(lo) | (f2bf(hi) << 16); }
__device__ __forceinline__ float bflo(unsigned w) { return __uint_as_float(w << 16); }
__device__ __forceinline__ float bfhi(unsigned w) { return __uint_as_float(w & 0xffff0000u); }
__device__ __forceinline__ float bf2f(bf16 v) { return __uint_as_float(((unsigned)v) << 16); }
__device__ __forceinline__ float wave_sum(float v) {
#pragma unroll
    for (int o = 1; o < 64; o <<= 1) v += __shfl_xor(v, o);
    return v;
}
__device__ __forceinline__ float wave_max(float v) {
#pragma unroll
    for (int o = 1; o < 64; o <<= 1) v = fmaxf(v, __shfl_xor(v, o));
    return v;
}

struct Args { const float* in[30]; float* out; unsigned char* ws; int ph_lo, ph_hi; };
enum { I_X = 0, I_MEM, I_F1IN, I_F1OUT, I_LN1G, I_LN1B, I_WIN, I_CONVW, I_CONVB, I_DTB, I_ALOG, I_DSKIP, I_SSDNW, I_KVNW, I_WUK, I_WUV, I_WPS, I_WPA, I_WOUT, I_LN2G, I_LN2B,
       I_WMQ, I_WMKV, I_WMO, I_LN3G, I_LN3B, I_F2IN, I_F2OUT, I_LN4G, I_LN4B };

__device__ __forceinline__ int srccol(int mode, int n) {
    if (mode == 0) return n;
    if (mode == 1) { const int tile = n >> 8, w = n & 255; return (w >> 7) * DFF + tile * 128 + (w & 127); }
    if (mode == 2) {
        if (n < 1024) return 2048 + n;
        if (n < 3072) return 3072 + (n - 1024);
        if (n < 4096) return 5136 + (n - 3072);
        if (n < 5120) return 6416 + (n - 4096);
        if (n < 5376) return 6160 + (n - 5120);
        n -= 5376;
        if (n < 64) return 7440 + n;
        if (n < 80) return 5120 + (n - 64);
        if (n < 96) return 7504 + (n - 80);
        return -1;
    }
    if (mode == 3) return n;
    return 1024 + n;
}
__device__ __forceinline__ void transpose_item(const float* W, int K, int ldw, bf16* WT, int nout, int mode, float* scr, int item, int lane) {
    const int nblk = nout / 32, kb = item / nblk, nb = item % nblk, k0 = 64 * kb, n0 = 32 * nb;
    const int sc = srccol(mode, n0 + (lane & 31));
#pragma unroll 8
    for (int i = 0; i < 32; ++i) { const int kk = 2 * i + (lane >> 5); scr[kk * 33 + (lane & 31)] = sc >= 0 ? W[(size_t)(k0 + kk) * ldw + sc] : 0.f; }
    __builtin_amdgcn_s_waitcnt(0xc07f); asm volatile("" ::: "memory");
    const int c = lane & 7;
#pragma unroll
    for (int j = 0; j < 4; ++j) { const int n = (lane >> 3) + 8 * j; const float* s = scr + (8 * c) * 33 + n;
        v4u o; o.x = pk2(s[0 * 33], s[1 * 33]); o.y = pk2(s[2 * 33], s[3 * 33]); o.z = pk2(s[4 * 33], s[5 * 33]); o.w = pk2(s[6 * 33], s[7 * 33]);
        *(v4u*)(WT + (size_t)(n0 + n) * K + k0 + 8 * c) = o; }
    __builtin_amdgcn_s_waitcnt(0xc07f); asm volatile("" ::: "memory");
}
__device__ __forceinline__ void run_tr(const float* W, int K, int ldw, bf16* WT, int nout, int mode, float* scr, int gw, int NGW, int lane, int& base) {
    const int items = (K / 64) * (nout / 32);
    int it = gw - (base % NGW); if (it < 0) it += NGW;
    for (; it < items; it += NGW) transpose_item(W, K, ldw, WT, nout, mode, scr, it, lane);
    base += items;
}
__device__ __forceinline__ void cvt_rows(const float* src, bf16* dst, size_t n4, int gtid, int NGT) {
    for (size_t i = gtid; i < n4; i += NGT) { const f32x4 v = ((const f32x4*)src)[i]; v2u o; o.x = pk2(v[0], v[1]); o.y = pk2(v[2], v[3]); ((v2u*)dst)[i] = o; }
}

__device__ __forceinline__ void ln_rows(const float* V, const float* g, const float* b, bf16* xb, float* outf, int gw, int NGW, int lane) {
    f32x4 gv[4], bv[4];
#pragma unroll
    for (int j = 0; j < 4; ++j) { gv[j] = ((const f32x4*)g)[lane + 64 * j]; bv[j] = ((const f32x4*)b)[lane + 64 * j]; }
    for (int m = gw; m < T; m += NGW) {
        const f32x4* xr = (const f32x4*)(V + (size_t)m * D) + lane;
        f32x4 v[4]; float s = 0.f;
#pragma unroll
        for (int j = 0; j < 4; ++j) { v[j] = xr[64 * j]; s += (v[j][0] + v[j][1]) + (v[j][2] + v[j][3]); }
        const float mean = wave_sum(s) * (1.f / D); float s2 = 0.f;
#pragma unroll
        for (int j = 0; j < 4; ++j) { v[j] = v[j] - mean; s2 += (v[j][0] * v[j][0] + v[j][1] * v[j][1]) + (v[j][2] * v[j][2] + v[j][3] * v[j][3]); }
        const float rstd = 1.f / sqrtf(wave_sum(s2) * (1.f / D) + LN_EPS);
#pragma unroll
        for (int j = 0; j < 4; ++j) {
            const f32x4 o = v[j] * rstd * gv[j] + bv[j];
            if (xb) { v2u w; w.x = pk2(o[0], o[1]); w.y = pk2(o[2], o[3]); ((v2u*)(xb + (size_t)m * D))[lane + 64 * j] = w; }
            if (outf) ((f32x4*)(outf + (size_t)m * D))[lane + 64 * j] = o;
        }
    }
}

__device__ __forceinline__ void ssd_scan_naive(const Args& a, unsigned char* lds_raw, int unit) {
    const int tid = threadIdx.x, lane = tid & 63;
    const int b = unit >> 6, h = (unit >> 2) & 15, pq = unit & 3, g = h >> 2;
    const bf16* XBC = (const bf16*)(a.ws + WS_XBC); const float* DT = (const float*)((unsigned char*)a.out + DO_DT);
    bf16* YB = (bf16*)((unsigned char*)a.out + DO_YB);
    const float* convw = a.in[I_CONVW]; const float* convb = a.in[I_CONVB];
    const float A = -__expf(a.in[I_ALOG][h]), Dsk = a.in[I_DSKIP][h];
    float* sx = (float*)lds_raw;
    float* sB = sx + 64 * 16;
    float* sC = sB + 64 * 128;
    float* sdt = sC + 64 * 128;
    float* sy = sdt + 64;
    const int p = tid >> 5, nl = tid & 31;
    float hs0 = 0.f, hs1 = 0.f, hs2 = 0.f, hs3 = 0.f;
    for (int t0 = 0; t0 < SEQ; t0 += 64) {
        __syncthreads();
        for (int e = tid; e < 64 * 272; e += NTHR) {
            const int row = e / 272, cc = e % 272;
            const int col = cc < 16 ? (h * 64 + pq * 16 + cc) : (cc < 144 ? (1024 + g * 128 + (cc - 16)) : (1536 + g * 128 + (cc - 144)));
            const int t = t0 + row;
            float accv = convb[col];
#pragma unroll
            for (int k = 0; k < 4; ++k) { const int tt = t - 3 + k; if (tt >= 0) accv += convw[k * 2048 + col] * bf2f(XBC[((size_t)(b * SEQ + tt)) * 2048 + col]); }
            const float v = accv / (1.f + __expf(-accv));
            if (cc < 16) sx[row * 16 + cc] = v; else if (cc < 144) sB[row * 128 + (cc - 16)] = v; else sC[row * 128 + (cc - 144)] = v;
        }
        if (tid < 64) sdt[tid] = DT[(size_t)(b * SEQ + t0 + tid) * 16 + h];
        __syncthreads();
        for (int l = 0; l < 64; ++l) {
            const float dtv = sdt[l], dec = __expf(dtv * A), xr = sx[l * 16 + p], xv = xr * dtv;
            const f32x4 Bv = *(const f32x4*)(sB + l * 128 + nl * 4), Cv = *(const f32x4*)(sC + l * 128 + nl * 4);
            hs0 = hs0 * dec + xv * Bv[0]; hs1 = hs1 * dec + xv * Bv[1]; hs2 = hs2 * dec + xv * Bv[2]; hs3 = hs3 * dec + xv * Bv[3];
            float part = (hs0 * Cv[0] + hs1 * Cv[1]) + (hs2 * Cv[2] + hs3 * Cv[3]);
#pragma unroll
            for (int o = 1; o < 32; o <<= 1) part += __shfl_xor(part, o);
            if (nl == 0) sy[l * 16 + p] = part + Dsk * xr;
        }
        __syncthreads();
        for (int e = tid; e < 64 * 16; e += NTHR) { const int row = e >> 4, cc = e & 15; YB[(size_t)(b * SEQ + t0 + row) * 1024 + h * 64 + pq * 16 + cc] = (bf16)f2bf(sy[e]); }
    }
    (void)lane;
}
__device__ __forceinline__ void ssd_gate_norm(const Args& a, int gw, int NGW, int lane) {
    const bf16* YB = (const bf16*)((unsigned char*)a.out + DO_YB); bf16* ZS = (bf16*)(a.ws + WS_Z); const float* nw = a.in[I_SSDNW];
    for (int m = gw; m < T; m += NGW) {
#pragma unroll
        for (int g = 0; g < 4; ++g) {
            const size_t off = (size_t)m * 1024 + g * 256 + lane * 4;
            const v2u yw = *(const v2u*)(YB + off), zw = *(const v2u*)(ZS + off);
            float v[4] = {bflo(yw.x) * bflo(zw.x), bfhi(yw.x) * bfhi(zw.x), bflo(yw.y) * bflo(zw.y), bfhi(yw.y) * bfhi(zw.y)};
            const float ss = wave_sum((v[0] * v[0] + v[1] * v[1]) + (v[2] * v[2] + v[3] * v[3]));
            const float rs = 1.f / sqrtf(ss * (1.f / 256.f) + RMS_EPS);
            const f32x4 w = *(const f32x4*)(nw + g * 256 + lane * 4);
            v2u o; o.x = pk2(v[0] * rs * w[0], v[1] * rs * w[1]); o.y = pk2(v[2] * rs * w[2], v[3] * rs * w[3]);
            *(v2u*)(ZS + off) = o;
        }
    }
}
__device__ __forceinline__ void ckv_norm(const Args& a, int gw, int NGW, int lane) {
    const float* CKV = (const float*)((unsigned char*)a.out + DO_CKV); bf16* CKVN = (bf16*)(a.ws + WS_CKVN); const float* nw = a.in[I_KVNW];
    const f32x4 w = *(const f32x4*)(nw + lane * 4);
    for (int m = gw; m < T; m += NGW) {
        const f32x4 v = *(const f32x4*)(CKV + (size_t)m * 256 + lane * 4);
        const float ss = wave_sum((v[0] * v[0] + v[1] * v[1]) + (v[2] * v[2] + v[3] * v[3]));
        const float rs = 1.f / sqrtf(ss * (1.f / 256.f) + RMS_EPS);
        v2u o; o.x = pk2(v[0] * rs * w[0], v[1] * rs * w[1]); o.y = pk2(v[2] * rs * w[2], v[3] * rs * w[3]);
        *(v2u*)(CKVN + (size_t)m * 256 + lane * 4) = o;
    }
}

__device__ __forceinline__ unsigned f2sortable(float f) { const unsigned u = __float_as_uint(f); return (u & 0x80000000u) ? ~u : (u | 0x80000000u); }
__device__ __forceinline__ void indexer_topk_naive(const Args& a, unsigned char* lds_raw, int q) {
    const int tid = threadIdx.x, lane = tid & 63, wave = tid >> 6;
    const int b = q / SEQ, t = q % SEQ;
    const bf16* QI = (const bf16*)(a.ws + WS_QI); const bf16* KIDX = (const bf16*)(a.ws + WS_KIDX); const float* WIDX = (const float*)((unsigned char*)a.out + DO_WIDX);
    unsigned short* IDX = (unsigned short*)((unsigned char*)a.out + DO_IDX) + (size_t)q * 256;
    float* sq = (float*)lds_raw;
    float* sw = sq + 1024;
    unsigned* ssc = (unsigned*)(sw + 16);
    unsigned* wcnt = ssc + 4096;
    unsigned* misc = wcnt + 16;
    __syncthreads();
    if (t < 256) { if (tid < 256) IDX[tid] = tid <= t ? (unsigned short)tid : (unsigned short)0xFFFF; return; }
    for (int e = tid; e < 1024; e += NTHR) sq[e] = bf2f(QI[(size_t)q * 1024 + e]);
    if (tid < 16) sw[tid] = WIDX[(size_t)q * 16 + tid];
    if (tid == 0) { misc[0] = 0u; }
    __syncthreads();
    const int nvalid = t + 1;
#pragma unroll 1
    for (int jj = 0; jj < 8; ++jj) {
        const int s = tid + NTHR * jj;
        unsigned u = 0u;
        if (s < nvalid) {
            float kf[64];
            const v4u* kp = (const v4u*)(KIDX + (size_t)(b * SEQ + s) * 64);
#pragma unroll
            for (int c = 0; c < 8; ++c) { const v4u w = kp[c]; kf[8 * c] = bflo(w.x); kf[8 * c + 1] = bfhi(w.x); kf[8 * c + 2] = bflo(w.y); kf[8 * c + 3] = bfhi(w.y); kf[8 * c + 4] = bflo(w.z); kf[8 * c + 5] = bfhi(w.z); kf[8 * c + 6] = bflo(w.w); kf[8 * c + 7] = bfhi(w.w); }
            float sc = 0.f;
#pragma unroll 1
            for (int hh = 0; hh < 16; ++hh) {
                float d0 = 0.f, d1 = 0.f;
#pragma unroll
                for (int d = 0; d < 64; d += 4) { const f32x4 qv = *(const f32x4*)(sq + hh * 64 + d); d0 += qv[0] * kf[d] + qv[2] * kf[d + 2]; d1 += qv[1] * kf[d + 1] + qv[3] * kf[d + 3]; }
                sc += sw[hh] * fmaxf(d0 + d1, 0.f);
            }
            u = f2sortable(sc);
        }
        ssc[s] = u;
    }
    __syncthreads();
    unsigned tau = 0u;
    for (int bit = 31; bit >= 0; --bit) {
        const unsigned cand = tau | (1u << bit);
        unsigned c = 0;
#pragma unroll
        for (int jj = 0; jj < 8; ++jj) c += (unsigned)__popcll(__ballot(ssc[tid + NTHR * jj] >= cand));
        unsigned* wc_ = wcnt + (bit & 1) * 8;
        if (lane == 0) wc_[wave] = c;
        __syncthreads();
        unsigned tot = 0;
#pragma unroll
        for (int w = 0; w < 8; ++w) tot += wc_[w];
        if (tot >= 256u) tau = cand;
    }
    unsigned cgt = 0;
    {
        unsigned c = 0;
#pragma unroll
        for (int jj = 0; jj < 8; ++jj) c += (unsigned)__popcll(__ballot(ssc[tid + NTHR * jj] > tau));
        __syncthreads();
        if (lane == 0) wcnt[wave] = c;
        __syncthreads();
#pragma unroll
        for (int w = 0; w < 8; ++w) cgt += wcnt[w];
    }
    const unsigned need_eq = 256u - cgt;
    unsigned gt_run = 0, eq_run = 0;
    for (int jj = 0; jj < 8; ++jj) {
        const int s = tid + NTHR * jj; const unsigned u = ssc[s];
        const bool gt = (u > tau), eq = (u == tau);
        const unsigned long long bg = __ballot(gt), be = __ballot(eq), lm = (1ull << lane) - 1ull;
        const unsigned ing = (unsigned)__popcll(bg & lm), ine = (unsigned)__popcll(be & lm);
        __syncthreads();
        if (lane == 0) wcnt[wave] = (unsigned)__popcll(bg) | ((unsigned)__popcll(be) << 16);
        __syncthreads();
        unsigned bgt = gt_run, beq = eq_run, allg = 0, alle = 0;
#pragma unroll
        for (int w = 0; w < 8; ++w) { const unsigned cw = wcnt[w]; if (w < wave) { bgt += cw & 0xffffu; beq += cw >> 16; } allg += cw & 0xffffu; alle += cw >> 16; }
        if (gt) IDX[bgt + ing] = (unsigned short)s;
        if (eq) { const unsigned r = beq + ine; if (r < need_eq) IDX[cgt + r] = (unsigned short)s; }
        gt_run += allg; eq_run += alle;
    }
}

__device__ __forceinline__ void sparse_attn_naive(const Args& a, unsigned char* lds_raw, int q) {
    const int tid = threadIdx.x, lane = tid & 63, wave = tid >> 6;
    const int b = q / SEQ, t = q % SEQ;
    bf16* Qb = (bf16*)(a.ws + WS_Q); const bf16* CKVN = (const bf16*)(a.ws + WS_CKVN);
    const unsigned short* IDX = (const unsigned short*)((unsigned char*)a.out + DO_IDX) + (size_t)q * 256;
    const float* wuk = a.in[I_WUK]; const float* wuv = a.in[I_WUV];
    float* sq = (float*)lds_raw;
    float* sql = sq + 1024;
    float* ss = sql + 4096;
    float* so = ss + 4096;
    int* sidx = (int*)(so + 4096);
    __syncthreads();
    for (int e = tid; e < 1024; e += NTHR) sq[e] = bf2f(Qb[(size_t)q * 1024 + e]);
    if (tid < 256) { const int id = IDX[tid]; sidx[tid] = (id == 0xFFFF || id > t) ? -1 : id; }
    __syncthreads();
    {
        const int h = tid >> 5, r8 = (tid & 31) * 8;
        float acc[8] = {0.f, 0.f, 0.f, 0.f, 0.f, 0.f, 0.f, 0.f};
#pragma unroll 2
        for (int d = 0; d < 64; ++d) {
            const float qd = sq[h * 64 + d]; const float* wp = wuk + ((size_t)(h * 64 + d)) * 256 + r8;
            const f32x4 w0 = *(const f32x4*)wp, w1 = *(const f32x4*)(wp + 4);
#pragma unroll
            for (int i = 0; i < 4; ++i) { acc[i] += qd * w0[i]; acc[4 + i] += qd * w1[i]; }
        }
#pragma unroll
        for (int i = 0; i < 8; ++i) sql[h * 256 + r8 + i] = acc[i] * 0.125f;
    }
    __syncthreads();
    {
        const int k = tid >> 1, hh = tid & 1, id = sidx[k];
        float acc[8] = {0.f, 0.f, 0.f, 0.f, 0.f, 0.f, 0.f, 0.f};
        if (id >= 0) {
            const v4u* cp = (const v4u*)(CKVN + (size_t)(b * SEQ + id) * 256);
#pragma unroll 1
            for (int r0 = 0; r0 < 256; r0 += 8) {
                const v4u w = cp[r0 >> 3];
                const float c[8] = {bflo(w.x), bfhi(w.x), bflo(w.y), bfhi(w.y), bflo(w.z), bfhi(w.z), bflo(w.w), bfhi(w.w)};
#pragma unroll
                for (int hl = 0; hl < 8; ++hl) {
                    const float* qp = sql + (hh * 8 + hl) * 256 + r0;
                    const f32x4 q0 = *(const f32x4*)qp, q1 = *(const f32x4*)(qp + 4);
                    acc[hl] += (q0[0] * c[0] + q0[1] * c[1]) + (q0[2] * c[2] + q0[3] * c[3]) + (q1[0] * c[4] + q1[1] * c[5]) + (q1[2] * c[6] + q1[3] * c[7]);
                }
            }
        }
#pragma unroll
        for (int hl = 0; hl < 8; ++hl) {
            const int h = hh * 8 + hl; const float slope = exp2f(-0.5f * (float)(h + 1));
            ss[h * 256 + k] = id >= 0 ? acc[hl] - slope * (float)(t - id) : -INFINITY;
        }
    }
    __syncthreads();
    {
#pragma unroll
        for (int hl = 0; hl < 2; ++hl) {
            float* row = ss + (wave * 2 + hl) * 256;
            float v[4]; float mx = -INFINITY;
#pragma unroll
            for (int i = 0; i < 4; ++i) { v[i] = row[lane + 64 * i]; mx = fmaxf(mx, v[i]); }
            mx = wave_max(mx);
            float sum = 0.f;
#pragma unroll
            for (int i = 0; i < 4; ++i) { v[i] = __expf(v[i] - mx); sum += v[i]; }
            sum = wave_sum(sum);
            const float inv = 1.f / sum;
#pragma unroll
            for (int i = 0; i < 4; ++i) row[lane + 64 * i] = v[i] * inv;
        }
    }
    __syncthreads();
    {
        const int r = tid & 255, hh = tid >> 8;
        float acc[8] = {0.f, 0.f, 0.f, 0.f, 0.f, 0.f, 0.f, 0.f};
#pragma unroll 2
        for (int k = 0; k < 256; ++k) {
            const int id = sidx[k]; if (id < 0) continue;
            const float c = bf2f(CKVN[(size_t)(b * SEQ + id) * 256 + r]);
#pragma unroll
            for (int hl = 0; hl < 8; ++hl) acc[hl] += ss[(hh * 8 + hl) * 256 + k] * c;
        }
#pragma unroll
        for (int hl = 0; hl < 8; ++hl) so[(hh * 8 + hl) * 256 + r] = acc[hl];
    }
    __syncthreads();
    {
        const int h = tid >> 5, d2 = (tid & 31) * 2;
        float a0 = 0.f, a1 = 0.f;
#pragma unroll 4
        for (int r = 0; r < 256; ++r) { const float o = so[h * 256 + r]; const f32x2 w = *(const f32x2*)(wuv + ((size_t)(h * 256 + r)) * 64 + d2); a0 += o * w[0]; a1 += o * w[1]; }
        *(unsigned*)(Qb + (size_t)q * 1024 + h * 64 + d2) = pk2(a0, a1);
    }
}

__device__ __forceinline__ void mem_attn_naive(const Args& a, unsigned char* lds_raw, int q) {
    const int tid = threadIdx.x, lane = tid & 63, wave = tid >> 6;
    const int b = q / SEQ;
    bf16* QM = (bf16*)(a.ws + WS_Z); const bf16* KVM = (const bf16*)(a.ws + WS_KVM);
    float* sq = (float*)lds_raw;
    float* ss = sq + 1024;
    __syncthreads();
    for (int e = tid; e < 1024; e += NTHR) sq[e] = bf2f(QM[(size_t)q * 1024 + e]);
    __syncthreads();
    {
        const int m = tid & 255, hp = tid >> 8;
#pragma unroll
        for (int hl = 0; hl < 2; ++hl) {
            const int hd = hp * 2 + hl;
            const v4u* kp = (const v4u*)(KVM + (size_t)(b * MEML + m) * 2048 + hd * 256);
            float acc = 0.f;
            for (int c = 0; c < 32; ++c) {
                const v4u w = kp[c]; const float* qp = sq + hd * 256 + c * 8;
                const f32x4 q0 = *(const f32x4*)qp, q1 = *(const f32x4*)(qp + 4);
                acc += (q0[0] * bflo(w.x) + q0[1] * bfhi(w.x)) + (q0[2] * bflo(w.y) + q0[3] * bfhi(w.y)) + (q1[0] * bflo(w.z) + q1[1] * bfhi(w.z)) + (q1[2] * bflo(w.w) + q1[3] * bfhi(w.w));
            }
            ss[hd * 256 + m] = acc * 0.0625f;
        }
    }
    __syncthreads();
    if (wave < 4) {
        float* row = ss + wave * 256;
        float v[4]; float mx = -INFINITY;
#pragma unroll
        for (int i = 0; i < 4; ++i) { v[i] = row[lane + 64 * i]; mx = fmaxf(mx, v[i]); }
        mx = wave_max(mx);
        float sum = 0.f;
#pragma unroll
        for (int i = 0; i < 4; ++i) { v[i] = __expf(v[i] - mx); sum += v[i]; }
        sum = wave_sum(sum);
        const float inv = 1.f / sum;
#pragma unroll
        for (int i = 0; i < 4; ++i) row[lane + 64 * i] = v[i] * inv;
    }
    __syncthreads();
    {
        const int c = tid * 2, hd = c >> 8;
        float a0 = 0.f, a1 = 0.f;
        for (int m = 0; m < 256; ++m) { const float p = ss[hd * 256 + m]; const unsigned w = *(const unsigned*)(KVM + (size_t)(b * MEML + m) * 2048 + 1024 + c); a0 += p * bflo(w); a1 += p * bfhi(w); }
        *(unsigned*)(QM + (size_t)q * 1024 + c) = pk2(a0, a1);
    }
}

enum { PH_PREP = 0, PH_FFN1_IN, PH_FFN1_OUT, PH_LN1, PH_INPROJ, PH_SSD_SCAN, PH_SSD_NORM, PH_INDEXER, PH_ATTN, PH_MERGE, PH_WOUT, PH_LN2, PH_QM, PH_MEMATTN, PH_WMO, PH_LN3,
       PH_FFN2_IN, PH_FFN2_OUT, PH_LN4, N_PHASES };

template <class Epi> __device__ __forceinline__ void run_gemm(LAS unsigned char* lds, const bf16* A, const bf16* Bt, int M, int N, int K, const Epi& E) {
    pg8::Gemm g{A, Bt, M, N, K}; pg8::StaticOrder S; S.init(M, N, (int)gridDim.x, (int)blockIdx.x);
    pg8::gemm_phase<Epi, pg8::StaticOrder, true, true>(lds, g, S, E);
}

template <int ph> __device__ __forceinline__ void run_phase(const Args& a, unsigned char* lds) {
    LAS unsigned char* ldsl = (LAS unsigned char*)lds;
    const int tid = threadIdx.x, lane = tid & 63, wave = __builtin_amdgcn_readfirstlane(tid >> 6);
    const int G = gridDim.x, bx = blockIdx.x;
    const int gw = bx * NWAVES + wave, NGW = G * NWAVES, gtid = bx * NTHR + tid, NGT = G * NTHR;
    unsigned char* ws = a.ws; unsigned char* dob = (unsigned char*)a.out;
    bf16* XB = (bf16*)(ws + WS_XB);
    {
        switch (ph) {
        case PH_PREP: {
            float* scr = (float*)(lds + wave * 16384);
            int base = 0;
            run_tr(a.in[I_F1IN], 1024, 2 * DFF, (bf16*)(ws + WS_WA_IN), 2 * DFF, 1, scr, gw, NGW, lane, base);
            run_tr(a.in[I_F1OUT], DFF, 1024, (bf16*)(ws + WS_WA_OUT), 1024, 0, scr, gw, NGW, lane, base);
            run_tr(a.in[I_WIN], 1024, WIN_LD, (bf16*)(ws + WS_WIN), NIN, 2, scr, gw, NGW, lane, base);
            run_tr(a.in[I_WIN], 1024, WIN_LD, (bf16*)(ws + WS_WGS), 1024, 3, scr, gw, NGW, lane, base);
            run_tr(a.in[I_WIN], 1024, WIN_LD, (bf16*)(ws + WS_WGA), 1024, 4, scr, gw, NGW, lane, base);
            run_tr(a.in[I_WPS], 1024, 1024, (bf16*)(ws + WS_WPS), 1024, 0, scr, gw, NGW, lane, base);
            run_tr(a.in[I_WPA], 1024, 1024, (bf16*)(ws + WS_WPA), 1024, 0, scr, gw, NGW, lane, base);
            run_tr(a.in[I_WOUT], 1024, 1024, (bf16*)(ws + WS_WOUT), 1024, 0, scr, gw, NGW, lane, base);
            run_tr(a.in[I_WMQ], 1024, 1024, (bf16*)(ws + WS_WMQ), 1024, 0, scr, gw, NGW, lane, base);
            run_tr(a.in[I_WMO], 1024, 1024, (bf16*)(ws + WS_WMO), 1024, 0, scr, gw, NGW, lane, base);
            run_tr(a.in[I_WMKV], 1024, 2048, (bf16*)(ws + WS_WMKV), 2048, 0, scr, gw, NGW, lane, base);
            cvt_rows(a.in[I_X], XB, (size_t)T * D / 4, gtid, NGT);
            cvt_rows(a.in[I_MEM], (bf16*)(ws + WS_MEMB), (size_t)BATCH * MEML * D / 4, gtid, NGT);
        } break;
        case PH_FFN1_IN: {
            pg8::EpiSwiglu E{(bf16*)(ws + WS_H), DFF};
            run_gemm(ldsl, XB, (const bf16*)(ws + WS_WA_IN), T, 2 * DFF, D, E);
            pg8::EpiPlain E2{(bf16*)(ws + WS_KVM), 2048};
            run_gemm(ldsl, (const bf16*)(ws + WS_MEMB), (const bf16*)(ws + WS_WMKV), BATCH * MEML, 2048, D, E2);
        } break;
        case PH_FFN1_OUT: {
            pg8::EpiRes<false> E{a.in[I_X], (float*)dob, ALPHA, 0.5f};
            run_gemm(ldsl, (const bf16*)(ws + WS_H), (const bf16*)(ws + WS_WA_OUT), T, D, DFF, E);
        } break;
        case PH_LN1: ln_rows((const float*)dob, a.in[I_LN1G], a.in[I_LN1B], XB, nullptr, gw, NGW, lane); break;
        case PH_INPROJ: {
            pg8::EpiInproj E{(bf16*)(ws + WS_Z), (bf16*)(ws + WS_XBC), (bf16*)(ws + WS_Q), (bf16*)(ws + WS_QI), (bf16*)(ws + WS_KIDX),
                             (float*)(dob + DO_CKV), (float*)(dob + DO_DT), (float*)(dob + DO_WIDX), a.in[I_DTB]};
            run_gemm(ldsl, XB, (const bf16*)(ws + WS_WIN), T, NIN, D, E);
            __syncthreads();
            float* scr = (float*)(lds + wave * 16384);
            int base = 0;
            run_tr(a.in[I_F2IN], 1024, 2 * DFF, (bf16*)(ws + WS_WA_IN), 2 * DFF, 1, scr, gw, NGW, lane, base);
            run_tr(a.in[I_F2OUT], DFF, 1024, (bf16*)(ws + WS_WA_OUT), 1024, 0, scr, gw, NGW, lane, base);
        } break;
        case PH_SSD_SCAN: {
            for (int u = bx; u < 256; u += G) ssd_scan_naive(a, lds, u);
            ckv_norm(a, gw, NGW, lane);
        } break;
        case PH_SSD_NORM: ssd_gate_norm(a, gw, NGW, lane); break;
        case PH_INDEXER: for (int q = bx; q < T; q += G) indexer_topk_naive(a, lds, q); break;
        case PH_ATTN: for (int q = bx; q < T; q += G) sparse_attn_naive(a, lds, q); break;
        case PH_MERGE: {
            bf16* Sg1 = (bf16*)(ws + WS_QI); bf16* Sg2 = (bf16*)(dob + DO_SG2); float* Sm = (float*)(ws + WS_XBC); bf16* MG = (bf16*)(dob + DO_MERGED);
            { pg8::EpiMerge<0> E{Sg1, Sm, MG}; run_gemm(ldsl, XB, (const bf16*)(ws + WS_WGS), T, D, D, E); }
            { pg8::EpiMerge<1> E{Sg1, Sm, MG}; run_gemm(ldsl, (const bf16*)(ws + WS_Z), (const bf16*)(ws + WS_WPS), T, D, D, E); }
            { pg8::EpiMerge<0> E{Sg2, Sm, MG}; run_gemm(ldsl, XB, (const bf16*)(ws + WS_WGA), T, D, D, E); }
            { pg8::EpiMerge<2> E{Sg2, Sm, MG}; run_gemm(ldsl, (const bf16*)(ws + WS_Q), (const bf16*)(ws + WS_WPA), T, D, D, E); }
        } break;
        case PH_WOUT: {
            pg8::EpiRes<true> E{XB, (float*)(ws + WS_XBC), ALPHA, 1.0f};
            run_gemm(ldsl, (const bf16*)(dob + DO_MERGED), (const bf16*)(ws + WS_WOUT), T, D, D, E);
        } break;
        case PH_LN2: ln_rows((const float*)(ws + WS_XBC), a.in[I_LN2G], a.in[I_LN2B], XB, nullptr, gw, NGW, lane); break;
        case PH_QM: {
            pg8::EpiPlain E{(bf16*)(ws + WS_Z), 1024};
            run_gemm(ldsl, XB, (const bf16*)(ws + WS_WMQ), T, D, D, E);
        } break;
        case PH_MEMATTN: for (int q = bx; q < T; q += G) mem_attn_naive(a, lds, q); break;
        case PH_WMO: {
            pg8::EpiRes<true> E{XB, (float*)dob, ALPHA, 1.0f};
            run_gemm(ldsl, (const bf16*)(ws + WS_Z), (const bf16*)(ws + WS_WMO), T, D, D, E);
        } break;
        case PH_LN3: ln_rows((const float*)dob, a.in[I_LN3G], a.in[I_LN3B], XB, nullptr, gw, NGW, lane); break;
        case PH_FFN2_IN: {
            pg8::EpiSwiglu E{(bf16*)(ws + WS_H), DFF};
            run_gemm(ldsl, XB, (const bf16*)(ws + WS_WA_IN), T, 2 * DFF, D, E);
        } break;
        case PH_FFN2_OUT: {
            pg8::EpiRes<true> E{XB, (float*)dob, ALPHA, 0.5f};
            run_gemm(ldsl, (const bf16*)(ws + WS_H), (const bf16*)(ws + WS_WA_OUT), T, D, DFF, E);
        } break;
        case PH_LN4: ln_rows((const float*)dob, a.in[I_LN4G], a.in[I_LN4B], nullptr, (float*)dob, gw, NGW, lane); break;
        default: break;
        }
    }
}

template <int PH> __global__ void __launch_bounds__(NTHR, 2) k_phase(Args a) {
    extern __shared__ __attribute__((aligned(16))) unsigned char lds[];
    run_phase<PH>(a, lds);
}
template <int PH> __device__ __forceinline__ void mega_phases(const Args& a, unsigned char* lds, cooperative_groups::grid_group& grid) {
    if constexpr (PH < N_PHASES) {
        if (PH >= a.ph_lo && PH < a.ph_hi) { run_phase<PH>(a, lds); if (PH + 1 < a.ph_hi) grid.sync(); }
        mega_phases<PH + 1>(a, lds, grid);
    }
}
__global__ void __launch_bounds__(NTHR, 2) hybrid_mega(Args a) {
    extern __shared__ __attribute__((aligned(16))) unsigned char lds[];
    cooperative_groups::grid_group grid = cooperative_groups::this_grid();
    mega_phases<0>(a, lds, grid);
}
#ifndef MEGA
#define MEGA 1
#endif
template <int PH> static void launch_phase(const Args& a, int grid, hipStream_t stream) {
    static bool attr = false;
    if (!attr) { (void)hipFuncSetAttribute((const void*)k_phase<PH>, hipFuncAttributeMaxDynamicSharedMemorySize, LDS_BYTES); attr = true; }
    hipLaunchKernelGGL(k_phase<PH>, dim3(grid), dim3(NTHR), LDS_BYTES, stream, a);
}
template <int PH> static void launch_all(const Args& a, int grid, hipStream_t stream) {
    if constexpr (PH < N_PHASES) { launch_phase<PH>(a, grid, stream); launch_all<PH + 1>(a, grid, stream); }
}

#ifndef CUT_PHASE
#define CUT_PHASE -1
#endif
#ifndef CUT_SRC
#define CUT_SRC WS_XB
#endif
__global__ void __launch_bounds__(NTHR) k_dump(Args a) {
    const bf16* src = (const bf16*)(a.ws + CUT_SRC);
    const size_t n = (size_t)T * D;
    for (size_t i = (size_t)blockIdx.x * NTHR + threadIdx.x; i < n; i += (size_t)gridDim.x * NTHR) a.out[i] = bf2f(src[i]);
}
template <int PH> static void launch_upto(const Args& a, int grid, hipStream_t stream) {
    if constexpr (PH < N_PHASES) { if (PH <= CUT_PHASE) { launch_phase<PH>(a, grid, stream); launch_upto<PH + 1>(a, grid, stream); } }
}

extern "C" void kernel_launch(void* const* d_in, const int* in_sizes, int n_in, void* d_out, int out_size, void* d_ws, size_t ws_size, hipStream_t stream) {
    static int grid = 0;
    if (grid == 0) {
        if (n_in != 30 || out_size != T * D || ws_size < WS_END) { fprintf(stderr, "kernel_launch: unexpected shapes n_in %d out %d ws %zu\n", n_in, out_size, ws_size); grid = -1; return; }
        grid = 256;
    }
    if (grid < 0) return;
    Args a{};
    for (int i = 0; i < 30; ++i) a.in[i] = (const float*)d_in[i];
    a.out = (float*)d_out; a.ws = (unsigned char*)d_ws;
    a.ph_lo = 0; a.ph_hi = N_PHASES;
    if (MEGA) {
        static bool attr = false;
        if (!attr) {
            (void)hipFuncSetAttribute((const void*)hybrid_mega, hipFuncAttributeMaxDynamicSharedMemorySize, LDS_BYTES);
            int per_cu = 0; (void)hipOccupancyMaxActiveBlocksPerMultiprocessor(&per_cu, (const void*)hybrid_mega, NTHR, LDS_BYTES);
            if (per_cu < 1) fprintf(stderr, "kernel_launch: occupancy query says %d blocks per CU\n", per_cu);
            attr = true;
        }
        void* args[] = {&a};
        hipError_t e = hipLaunchCooperativeKernel((const void*)hybrid_mega, dim3(grid), dim3(NTHR), args, LDS_BYTES, stream);
        if (e != hipSuccess) fprintf(stderr, "cooperative launch failed: %s\n", hipGetErrorString(e));
    } else if (CUT_PHASE < 0) launch_all<0>(a, grid, stream);
    else { launch_upto<0>(a, grid, stream); hipLaunchKernelGGL(k_dump, dim3(1024), dim3(NTHR), 0, stream, a); }
}
```

```cpp
#include <hip/hip_runtime.h>
#include <hip/hip_cooperative_groups.h>
#include <cstdio>
#include <cstdint>
namespace pg8 {
#define PG8_LAS __attribute__((address_space(3)))
typedef unsigned short bf16_t;
typedef short bf16x8 __attribute__((ext_vector_type(8)));
typedef float f32x4 __attribute__((ext_vector_type(4)));
typedef unsigned u32x4 __attribute__((ext_vector_type(4)));
constexpr int BM = 256, BK = 64, HALF = 128, HTB = HALF * BK * 2  , STAGE_BYTES = 8 * HTB, NXCD = 8, WGM = 8;

__host__ __device__ __forceinline__ int lds_byte(int r, int c) { const int st = (r >> 4) * 2 + (c >> 5), rr = r & 15, cc = c & 31, ob = rr * 64 + cc * 2; return st * 1024 + (ob ^ (((ob >> 9) & 1) << 5)); }
__host__ __device__ __forceinline__ void stage_rc(int b, int& R, int& C) { const int st = b / 1024, sb = b % 1024, swz = sb ^ (((sb >> 9) & 1) << 5); R = (st >> 1) * 16 + swz / 64; C = (st & 1) * 32 + (swz % 64) / 2; }
__host__ __device__ __forceinline__ int perm32(int rho) { const int n = rho >> 4, i = rho & 15; return 8 * (i >> 2) + 4 * n + (i & 3); }

struct Unit { int pm, pn; };
struct Gemm { const bf16_t* A; const bf16_t* Bt; int M, N, K; };

struct StaticOrder {
    int nM, nN, nwg, G, c;
    __host__ __device__ void init(int M, int N, int G_, int c_) { nM = M / BM; nN = N / BM; nwg = nM * nN; G = G_; c = c_; }
    __host__ __device__ bool next(int i, Unit& u) const {
        const long L = (long)i * G + c; if (L >= nwg) return false;
        int wgid = (int)L; { const int q = nwg / NXCD, r = nwg % NXCD, xcd = wgid % NXCD, off = wgid / NXCD; wgid = (xcd < r ? xcd * (q + 1) : r * (q + 1) + (xcd - r) * q) + off; }
        const int nig = WGM * nN, gid = wgid / nig, fm = gid * WGM, gsz = (nM - fm) < WGM ? (nM - fm) : WGM;
        u.pm = fm + ((wgid % nig) % gsz); u.pn = (wgid % nig) / gsz; return true;
    }
    __device__ __forceinline__ void a_ready(const Unit&) const {}
    __device__ __forceinline__ void done(const Unit&) const {}
};

typedef float f32x2 __attribute__((ext_vector_type(2)));
typedef __bf16 bf16x2_t __attribute__((ext_vector_type(2)));
__device__ __forceinline__ unsigned cvt_pk_bf16(float lo, float hi) { f32x2 v = {lo, hi}; bf16x2_t b = __builtin_convertvector(v, bf16x2_t); return __builtin_bit_cast(unsigned, b); }
typedef unsigned u32x2 __attribute__((ext_vector_type(2)));
__device__ __forceinline__ float sigm(float x) { return __builtin_amdgcn_rcpf(1.f + __expf(-x)); }
__device__ __forceinline__ float silu(float x) { return x * sigm(x); }
__device__ __forceinline__ float bf_lo(unsigned w) { return __uint_as_float(w << 16); }
__device__ __forceinline__ float bf_hi(unsigned w) { return __uint_as_float(w & 0xffff0000u); }
__device__ __forceinline__ u32x4 pack8(const float (&h)[8]) { u32x4 w; w.x = cvt_pk_bf16(h[0], h[1]); w.y = cvt_pk_bf16(h[2], h[3]); w.z = cvt_pk_bf16(h[4], h[5]); w.w = cvt_pk_bf16(h[6], h[7]); return w; }
__device__ __forceinline__ void unpack8(u32x4 w, float (&h)[8]) { h[0] = bf_lo(w.x); h[1] = bf_hi(w.x); h[2] = bf_lo(w.y); h[3] = bf_hi(w.y); h[4] = bf_lo(w.z); h[5] = bf_hi(w.z); h[6] = bf_lo(w.w); h[7] = bf_hi(w.w); }

struct EpiSwiglu {
    static constexpr bool PERM = true, AFTER_DRAIN = false;
    bf16_t* O; int ldo;
    __device__ __forceinline__ void operator()(const f32x4 (&acc)[2][2][4][2], const Unit& u, int wr, int wc, int fr, int fq) const {
        const int row0 = u.pm * BM + wr * 64 + fr, col0 = u.pn * 128 + wc * 32 + 8 * fq;
#pragma unroll
        for (int ai = 0; ai < 2; ++ai)
#pragma unroll
            for (int m = 0; m < 4; ++m) {
                float h[8];
#pragma unroll
                for (int n = 0; n < 2; ++n)
#pragma unroll
                    for (int i = 0; i < 4; ++i) h[n * 4 + i] = silu(acc[ai][0][m][n][i]) * acc[ai][1][m][n][i];
                *(u32x4*)(O + (size_t)(row0 + ai * HALF + m * 16) * ldo + col0) = pack8(h);
            }
    }
};
struct EpiPlain {
    static constexpr bool PERM = true, AFTER_DRAIN = false;
    bf16_t* O; int ldo;
    __device__ __forceinline__ void operator()(const f32x4 (&acc)[2][2][4][2], const Unit& u, int wr, int wc, int fr, int fq) const {
        const int row0 = u.pm * BM + wr * 64 + fr, col0 = u.pn * BM + wc * 32 + 8 * fq;
#pragma unroll
        for (int ai = 0; ai < 2; ++ai)
#pragma unroll
            for (int m = 0; m < 4; ++m)
#pragma unroll
                for (int bj = 0; bj < 2; ++bj) {
                    float h[8];
#pragma unroll
                    for (int n = 0; n < 2; ++n)
#pragma unroll
                        for (int i = 0; i < 4; ++i) h[n * 4 + i] = acc[ai][bj][m][n][i];
                    *(u32x4*)(O + (size_t)(row0 + ai * HALF + m * 16) * ldo + col0 + bj * HALF) = pack8(h);
                }
    }
};
template <bool BASE_BF16> struct EpiRes {
    static constexpr bool PERM = true, AFTER_DRAIN = false;
    const void* base; float* V; float alpha, scale;
    __device__ __forceinline__ void operator()(const f32x4 (&acc)[2][2][4][2], const Unit& u, int wr, int wc, int fr, int fq) const {
        const int row0 = u.pm * BM + wr * 64 + fr, col0 = u.pn * BM + wc * 32 + 8 * fq;
#pragma unroll
        for (int ai = 0; ai < 2; ++ai)
#pragma unroll
            for (int m = 0; m < 4; ++m)
#pragma unroll
                for (int bj = 0; bj < 2; ++bj) {
                    const size_t off = (size_t)(row0 + ai * HALF + m * 16) * 1024 + col0 + bj * HALF;
                    float b[8];
                    if (BASE_BF16) { unpack8(*(const u32x4*)((const bf16_t*)base + off), b); }
                    else { const f32x4 b0 = *(const f32x4*)((const float*)base + off), b1 = *(const f32x4*)((const float*)base + off + 4);
                        b[0] = b0[0]; b[1] = b0[1]; b[2] = b0[2]; b[3] = b0[3]; b[4] = b1[0]; b[5] = b1[1]; b[6] = b1[2]; b[7] = b1[3]; }
                    f32x4 v0, v1;
#pragma unroll
                    for (int i = 0; i < 4; ++i) { v0[i] = alpha * b[i] + scale * acc[ai][bj][m][0][i]; v1[i] = alpha * b[4 + i] + scale * acc[ai][bj][m][1][i]; }
                    *(f32x4*)(V + off) = v0; *(f32x4*)(V + off + 4) = v1;
                }
    }
};
struct EpiInproj {
    static constexpr bool PERM = true, AFTER_DRAIN = false;
    bf16_t *ZS, *XBC, *Q, *QI, *KIDX; float *CKV, *DT, *WIDX; const float* dt_bias;
    __device__ __forceinline__ void operator()(const f32x4 (&acc)[2][2][4][2], const Unit& u, int wr, int wc, int fr, int fq) const {
        const int row0 = u.pm * BM + wr * 64 + fr, lc0 = wc * 32 + 8 * fq, pn = u.pn;
#pragma unroll
        for (int ai = 0; ai < 2; ++ai)
#pragma unroll
            for (int m = 0; m < 4; ++m)
#pragma unroll
                for (int bj = 0; bj < 2; ++bj) {
                    const size_t row = (size_t)(row0 + ai * HALF + m * 16); const int lc = lc0 + bj * HALF;
                    float h[8];
#pragma unroll
                    for (int n = 0; n < 2; ++n)
#pragma unroll
                        for (int i = 0; i < 4; ++i) h[n * 4 + i] = acc[ai][bj][m][n][i];
                    if (pn < 4) {
#pragma unroll
                        for (int i = 0; i < 8; ++i) h[i] = silu(h[i]);
                        *(u32x4*)(ZS + row * 1024 + pn * 256 + lc) = pack8(h);
                    } else if (pn < 12) { *(u32x4*)(XBC + row * 2048 + (pn - 4) * 256 + lc) = pack8(h);
                    } else if (pn < 16) { *(u32x4*)(Q + row * 1024 + (pn - 12) * 256 + lc) = pack8(h);
                    } else if (pn < 20) { *(u32x4*)(QI + row * 1024 + (pn - 16) * 256 + lc) = pack8(h);
                    } else if (pn == 20) { *(f32x4*)(CKV + row * 256 + lc) = (f32x4){h[0], h[1], h[2], h[3]}; *(f32x4*)(CKV + row * 256 + lc + 4) = (f32x4){h[4], h[5], h[6], h[7]};
                    } else {
                        if (lc < 64) { *(u32x4*)(KIDX + row * 64 + lc) = pack8(h); }
                        else if (lc < 80) { const int h0 = lc - 64; float d[8];
#pragma unroll
                            for (int i = 0; i < 8; ++i) { const float xx = h[i] + dt_bias[h0 + i]; d[i] = xx > 20.f ? xx : __logf(1.f + __expf(xx)); }
                            *(f32x4*)(DT + row * 16 + h0) = (f32x4){d[0], d[1], d[2], d[3]}; *(f32x4*)(DT + row * 16 + h0 + 4) = (f32x4){d[4], d[5], d[6], d[7]}; }
                        else if (lc < 96) { const int h0 = lc - 80;
                            *(f32x4*)(WIDX + row * 16 + h0) = (f32x4){h[0] * 0.25f, h[1] * 0.25f, h[2] * 0.25f, h[3] * 0.25f}; *(f32x4*)(WIDX + row * 16 + h0 + 4) = (f32x4){h[4] * 0.25f, h[5] * 0.25f, h[6] * 0.25f, h[7] * 0.25f}; }
                    }
                }
    }
};
template <int MODE> struct EpiMerge {
    static constexpr bool PERM = true, AFTER_DRAIN = false;
    bf16_t* G; float* Sm; bf16_t* Out;
    __device__ __forceinline__ void operator()(const f32x4 (&acc)[2][2][4][2], const Unit& u, int wr, int wc, int fr, int fq) const {
        const int row0 = u.pm * BM + wr * 64 + fr, col0 = u.pn * BM + wc * 32 + 8 * fq;
#pragma unroll
        for (int ai = 0; ai < 2; ++ai)
#pragma unroll
            for (int m = 0; m < 4; ++m)
#pragma unroll
                for (int bj = 0; bj < 2; ++bj) {
                    const size_t off = (size_t)(row0 + ai * HALF + m * 16) * 1024 + col0 + bj * HALF;
                    float h[8];
#pragma unroll
                    for (int n = 0; n < 2; ++n)
#pragma unroll
                        for (int i = 0; i < 4; ++i) h[n * 4 + i] = acc[ai][bj][m][n][i];
                    if (MODE == 0) {
#pragma unroll
                        for (int i = 0; i < 8; ++i) h[i] = sigm(h[i]);
                        *(u32x4*)(G + off) = pack8(h);
                    } else if (MODE == 1) { float g[8]; unpack8(*(const u32x4*)(G + off), g);
                        *(f32x4*)(Sm + off) = (f32x4){g[0] * h[0], g[1] * h[1], g[2] * h[2], g[3] * h[3]}; *(f32x4*)(Sm + off + 4) = (f32x4){g[4] * h[4], g[5] * h[5], g[6] * h[6], g[7] * h[7]};
                    } else { float g[8]; unpack8(*(const u32x4*)(G + off), g); const f32x4 s0 = *(const f32x4*)(Sm + off), s1 = *(const f32x4*)(Sm + off + 4);
#pragma unroll
                        for (int i = 0; i < 4; ++i) { h[i] = s0[i] + g[i] * h[i]; h[4 + i] = s1[i] + g[4 + i] * h[4 + i]; }
                        *(u32x4*)(Out + off) = pack8(h); }
                }
    }
};
template <class Epi, class Sched, bool ALIGN_EPI = false, bool SP2 = false>
__device__ __forceinline__ void gemm_phase(PG8_LAS unsigned char* lds, const Gemm g, const Sched& S, const Epi& E) {
    const int tid = threadIdx.x, wid = __builtin_amdgcn_readfirstlane(tid >> 6), lane = tid & 63, wr = wid >> 2, wc = wid & 3, fr = lane & 15, fq = lane >> 4;
    const int K = g.K, nt = K / BK;
    unsigned voffA[2], voffB[2];
#pragma unroll
    for (int i = 0; i < 2; ++i) { int R, C; stage_rc(tid * 16 + i * 8192, R, C); const int Rb = Epi::PERM ? ((R & ~31) + perm32(R & 31)) : R;
        voffA[i] = (unsigned)(R * K + C) * 2u; voffB[i] = (unsigned)(Rb * K + C) * 2u; }
    const size_t kstep = (size_t)(BK * 2);
    const size_t hstep = (size_t)HALF * K * 2;
    const size_t tstep = 2 * hstep;
    const unsigned ldsw = (unsigned)wid * 1024u;
    const int aoff = lds_byte(wr * 64 + fr, fq * 8), boff = lds_byte(wc * 32 + fr, fq * 8);
#define PG8_SA(b, h) (((b) * 2 + (h)) * HTB)
#define PG8_SB(b, h) ((4 + (b) * 2 + (h)) * HTB)
#define PG8_STAGE(bufoff, gbase, voff) do { _Pragma("unroll") for (int _i = 0; _i < 2; ++_i) \
        __builtin_amdgcn_global_load_lds((const unsigned*)((const char*)(gbase) + (voff)[_i]), (PG8_LAS unsigned*)(lds + (bufoff) + ldsw + _i * 8192), 16, 0, 0); } while (0)
#define PG8_LDA(dst, b, h) do { _Pragma("unroll") for (int m = 0; m < 4; ++m) _Pragma("unroll") for (int k = 0; k < 2; ++k) dst[m][k] = *(const PG8_LAS bf16x8*)(lds + PG8_SA(b, h) + aoff + m * 2048 + k * 1024); } while (0)
#define PG8_LDB(dst, b, h) do { _Pragma("unroll") for (int n = 0; n < 2; ++n) _Pragma("unroll") for (int k = 0; k < 2; ++k) dst[n][k] = *(const PG8_LAS bf16x8*)(lds + PG8_SB(b, h) + boff + n * 2048 + k * 1024); } while (0)
#define PG8_MMA(ai, bj, At, Bt) do { __builtin_amdgcn_s_setprio(1); _Pragma("unroll") for (int m = 0; m < 4; ++m) _Pragma("unroll") for (int n = 0; n < 2; ++n) _Pragma("unroll") for (int k = 0; k < 2; ++k) \
        acc[ai][bj][m][n] = __builtin_amdgcn_mfma_f32_16x16x32_bf16(Bt[n][k], At[m][k], acc[ai][bj][m][n], 0, 0, 0); __builtin_amdgcn_s_setprio(0); } while (0)
#define PG8_WAIT_V(n) asm volatile("s_waitcnt vmcnt(" #n ")" ::: "memory")
#define PG8_WAIT_L(n) asm volatile("s_waitcnt lgkmcnt(" #n ")" ::: "memory")
#define PG8_BAR __builtin_amdgcn_s_barrier()
#define PG8_SCHED __builtin_amdgcn_sched_barrier(0)
    Unit cur, nxt; int ui = 0;
    if (!S.next(0, cur)) return;
    f32x4 acc[2][2][4][2];
#pragma unroll
    for (int a = 0; a < 2; ++a)
#pragma unroll
        for (int b = 0; b < 2; ++b)
#pragma unroll
            for (int m = 0; m < 4; ++m)
#pragma unroll
                for (int n = 0; n < 2; ++n) acc[a][b][m][n] = (f32x4){0.f, 0.f, 0.f, 0.f};
    bf16x8 At[4][2], B0[2][2], B1[2][2];
    const char* cA = (const char*)g.A + (size_t)cur.pm * tstep; const char* cB = (const char*)g.Bt + (size_t)cur.pn * tstep;
    S.a_ready(cur);
    if constexpr (SP2) {
        PG8_STAGE(PG8_SB(0, 0), cB, voffB); PG8_STAGE(PG8_SB(0, 1), cB + hstep, voffB); PG8_STAGE(PG8_SA(0, 0), cA, voffA); PG8_STAGE(PG8_SA(0, 1), cA + hstep, voffA);
        if (wr == 1) PG8_BAR;
        PG8_WAIT_V(2); PG8_BAR;
        PG8_STAGE(PG8_SB(1, 0), cB + kstep, voffB); PG8_STAGE(PG8_SA(1, 0), cA + kstep, voffA); PG8_STAGE(PG8_SB(1, 1), cB + hstep + kstep, voffB);
        PG8_WAIT_V(6); PG8_BAR;
    } else {
        PG8_STAGE(PG8_SB(0, 0), cB, voffB); PG8_STAGE(PG8_SA(0, 0), cA, voffA); PG8_STAGE(PG8_SB(0, 1), cB + hstep, voffB); PG8_STAGE(PG8_SA(0, 1), cA + hstep, voffA);
        if (wr == 1) PG8_BAR;
        PG8_WAIT_V(4); PG8_BAR;
        PG8_STAGE(PG8_SB(1, 0), cB + kstep, voffB); PG8_STAGE(PG8_SA(1, 0), cA + kstep, voffA); PG8_STAGE(PG8_SB(1, 1), cB + hstep + kstep, voffB);
        PG8_WAIT_V(6); PG8_BAR;
    }
    for (;;) {
        const bool has_next = S.next(ui + 1, nxt);
        const char* nA = has_next ? (const char*)g.A + (size_t)nxt.pm * tstep : cA; const char* nB = has_next ? (const char*)g.Bt + (size_t)nxt.pn * tstep : cB;
        for (int t = 0; t < nt; t += 2) {
            const bool last = (t == nt - 2);
            const char* a1 = cA + (size_t)(t + 1) * kstep;
            const char* a2 = last ? nA : cA + (size_t)(t + 2) * kstep; const char* b2 = last ? nB : cB + (size_t)(t + 2) * kstep;
            const char* a3 = a2 + kstep; const char* b3 = b2 + kstep;
            if (last && has_next) S.a_ready(nxt);
            if constexpr (SP2) {
            PG8_LDB(B0, 0, 0); PG8_LDB(B1, 0, 1); PG8_SCHED; PG8_LDA(At, 0, 0); PG8_STAGE(PG8_SA(1, 1), a1 + hstep, voffA);
            PG8_WAIT_V(8); PG8_WAIT_L(0); PG8_BAR; PG8_MMA(0, 0, At, B0); PG8_MMA(0, 1, At, B1); PG8_BAR; PG8_SCHED;
            PG8_LDA(At, 0, 1); PG8_STAGE(PG8_SB(0, 0), b2, voffB); PG8_STAGE(PG8_SB(0, 1), b2 + hstep, voffB); PG8_STAGE(PG8_SA(0, 0), a2, voffA);
            PG8_WAIT_V(8); PG8_WAIT_L(0); PG8_BAR; PG8_MMA(1, 0, At, B0); PG8_MMA(1, 1, At, B1); PG8_BAR; PG8_SCHED;
            PG8_LDB(B0, 1, 0); PG8_LDB(B1, 1, 1); PG8_SCHED; PG8_LDA(At, 1, 0); PG8_STAGE(PG8_SA(0, 1), a2 + hstep, voffA);
            PG8_WAIT_V(8); PG8_WAIT_L(0); PG8_BAR; PG8_MMA(0, 0, At, B0); PG8_MMA(0, 1, At, B1); PG8_BAR; PG8_SCHED;
            PG8_LDA(At, 1, 1); PG8_STAGE(PG8_SB(1, 0), b3, voffB); PG8_STAGE(PG8_SB(1, 1), b3 + hstep, voffB); PG8_STAGE(PG8_SA(1, 0), a3, voffA);
            PG8_WAIT_V(8); PG8_WAIT_L(0); PG8_BAR; PG8_MMA(1, 0, At, B0); PG8_MMA(1, 1, At, B1); PG8_BAR; PG8_SCHED;
            } else {
            PG8_LDB(B0, 0, 0); PG8_SCHED; PG8_LDA(At, 0, 0); PG8_STAGE(PG8_SA(1, 1), a1 + hstep, voffA);
            PG8_WAIT_L(8); PG8_BAR; PG8_WAIT_L(0); PG8_MMA(0, 0, At, B0); PG8_BAR; PG8_SCHED;
            PG8_LDB(B1, 0, 1); PG8_STAGE(PG8_SB(0, 0), b2, voffB);
            PG8_BAR; PG8_WAIT_L(0); PG8_MMA(0, 1, At, B1); PG8_BAR;
            PG8_LDA(At, 0, 1); PG8_STAGE(PG8_SA(0, 0), a2, voffA);
            PG8_BAR; PG8_WAIT_L(0); PG8_MMA(1, 0, At, B0); PG8_BAR; PG8_SCHED;
            PG8_STAGE(PG8_SB(0, 1), b2 + hstep, voffB);
            PG8_WAIT_V(6); PG8_BAR; PG8_MMA(1, 1, At, B1); PG8_BAR;
            PG8_LDB(B0, 1, 0); PG8_SCHED; PG8_LDA(At, 1, 0); PG8_STAGE(PG8_SA(0, 1), a2 + hstep, voffA);
            PG8_WAIT_L(8); PG8_BAR; PG8_WAIT_L(0); PG8_MMA(0, 0, At, B0); PG8_BAR; PG8_SCHED;
            PG8_LDB(B1, 1, 1); PG8_STAGE(PG8_SB(1, 0), b3, voffB);
            PG8_BAR; PG8_WAIT_L(0); PG8_MMA(0, 1, At, B1); PG8_BAR;
            PG8_LDA(At, 1, 1); PG8_STAGE(PG8_SA(1, 0), a3, voffA);
            PG8_BAR; PG8_WAIT_L(0); PG8_MMA(1, 0, At, B0); PG8_BAR; PG8_SCHED;
            PG8_STAGE(PG8_SB(1, 1), b3 + hstep, voffB);
            PG8_WAIT_V(6); PG8_BAR; PG8_MMA(1, 1, At, B1); PG8_BAR;
            }
        }
        if constexpr (ALIGN_EPI) { if (wr == 0) PG8_BAR; }
        if constexpr (!Epi::AFTER_DRAIN) { E(acc, cur, wr, wc, fr, fq); S.done(cur); }
        if (!has_next) break;
#pragma unroll
        for (int a = 0; a < 2; ++a)
#pragma unroll
            for (int b = 0; b < 2; ++b)
#pragma unroll
                for (int m = 0; m < 4; ++m)
#pragma unroll
                    for (int n = 0; n < 2; ++n) acc[a][b][m][n] = (f32x4){0.f, 0.f, 0.f, 0.f};
        cur = nxt; cA = nA; cB = nB; ++ui;
        if constexpr (ALIGN_EPI) { if (wr == 1) PG8_BAR; }
    }
    PG8_WAIT_V(0);
    if constexpr (!ALIGN_EPI) { if (wr == 0) PG8_BAR; }
    PG8_BAR;
    if constexpr (Epi::AFTER_DRAIN) { E.fused(acc, cur, wr, wc, fr, fq, lds, wid, lane); S.done(cur); }
#undef PG8_SA
#undef PG8_SB
#undef PG8_STAGE
#undef PG8_LDA
#undef PG8_LDB
#undef PG8_MMA
#undef PG8_WAIT_V
#undef PG8_WAIT_L
#undef PG8_BAR
#undef PG8_SCHED
}
}

#define LAS __attribute__((address_space(3)))
typedef unsigned short bf16;
typedef unsigned v4u __attribute__((ext_vector_type(4)));
typedef unsigned v2u __attribute__((ext_vector_type(2)));
typedef float f32x4 __attribute__((ext_vector_type(4)));
typedef float f32x2 __attribute__((ext_vector_type(2)));
constexpr int NWAVES = 8, NTHR = 512;
constexpr int BATCH = 4, SEQ = 4096, D = 1024, T = BATCH * SEQ, DFF = 2816, MEML = 256;
constexpr int NIN = 5632;
constexpr int WIN_LD = 7520;
constexpr float ALPHA = 1.189207115002721f;
constexpr float LN_EPS = 1e-5f, RMS_EPS = 1e-6f;
constexpr size_t MiB = 1u << 20;
constexpr size_t WS_CTL = 0;
constexpr size_t WS_WA_IN = 1 * MiB, WS_WA_OUT = 12 * MiB;
constexpr size_t WS_WIN = 18 * MiB;
constexpr size_t WS_WGS = 29 * MiB, WS_WGA = 31 * MiB, WS_WPS = 33 * MiB, WS_WPA = 35 * MiB, WS_WOUT = 37 * MiB, WS_WMQ = 39 * MiB, WS_WMO = 41 * MiB, WS_WMKV = 43 * MiB;
constexpr size_t WS_MEMB = 47 * MiB, WS_KVM = 49 * MiB;
constexpr size_t WS_WUK = 53 * MiB;
constexpr size_t WS_XB = 54 * MiB;
constexpr size_t WS_Z = 86 * MiB;
constexpr size_t WS_Q = 118 * MiB;
constexpr size_t WS_XBC = 150 * MiB;
constexpr size_t WS_QI = 214 * MiB;
constexpr size_t WS_CKVN = 246 * MiB;
constexpr size_t WS_KIDX = 254 * MiB;
constexpr size_t WS_H = 86 * MiB;
constexpr size_t WS_END = 256 * MiB;
constexpr size_t DO_CKV = 0, DO_DT = 16 * MiB, DO_WIDX = 17 * MiB, DO_IDX = 18 * MiB, DO_YB = 26 * MiB;
constexpr size_t DO_SG2 = 0, DO_MERGED = 32 * MiB;
constexpr int LDS_BYTES = 147456;

__device__ __forceinline__ unsigned f2bf(float f) { unsigned u = __builtin_bit_cast(unsigned, f); return (u + 0x7fffu + ((u >> 16) & 1u)) >> 16; }
__device__ __forceinline__ unsigned pk2(float lo, float hi) { return f2bf(lo) | (f2bf(hi) << 16); }
__device__ __forceinline__ float bflo(unsigned w) { return __uint_as_float(w << 16); }
__device__ __forceinline__ float bfhi(unsigned w) { return __uint_as_float(w & 0xffff0000u); }
__device__ __forceinline__ float bf2f(bf16 v) { return __uint_as_float(((unsigned)v) << 16); }
__device__ __forceinline__ float wave_sum(float v) {
#pragma unroll
    for (int o = 1; o < 64; o <<= 1) v += __shfl_xor(v, o);
    return v;
}
__device__ __forceinline__ float wave_max(float v) {
#pragma unroll
    for (int o = 1; o < 64; o <<= 1) v = fmaxf(v, __shfl_xor(v, o));
    return v;
}

struct Args { const float* in[30]; float* out; unsigned char* ws; int ph_lo, ph_hi; };
enum { I_X = 0, I_MEM, I_F1IN, I_F1OUT, I_LN1G, I_LN1B, I_WIN, I_CONVW, I_CONVB, I_DTB, I_ALOG, I_DSKIP, I_SSDNW, I_KVNW, I_WUK, I_WUV, I_WPS, I_WPA, I_WOUT, I_LN2G, I_LN2B,
       I_WMQ, I_WMKV, I_WMO, I_LN3G, I_LN3B, I_F2IN, I_F2OUT, I_LN4G, I_LN4B };

__device__ __forceinline__ int srccol(int mode, int n) {
    if (mode == 0) return n;
    if (mode == 1) { const int tile = n >> 8, w = n & 255; return (w >> 7) * DFF + tile * 128 + (w & 127); }
    if (mode == 2) {
        if (n < 1024) return 2048 + n;
        if (n < 3072) return 3072 + (n - 1024);
        if (n < 4096) return 5136 + (n - 3072);
        if (n < 5120) return 6416 + (n - 4096);
        if (n < 5376) return 6160 + (n - 5120);
        n -= 5376;
        if (n < 64) return 7440 + n;
        if (n < 80) return 5120 + (n - 64);
        if (n < 96) return 7504 + (n - 80);
        return -1;
    }
    if (mode == 3) return n;
    return 1024 + n;
}
__device__ __forceinline__ void transpose_item(const float* W, int K, int ldw, bf16* WT, int nout, int mode, float* scr, int item, int lane, float scale = 1.f) {
    const int nblk = nout / 32, kb = item / nblk, nb = item % nblk, k0 = 64 * kb, n0 = 32 * nb;
    const int sc = srccol(mode, n0 + (lane & 31));
#pragma unroll 8
    for (int i = 0; i < 32; ++i) { const int kk = 2 * i + (lane >> 5); scr[kk * 33 + (lane & 31)] = sc >= 0 ? W[(size_t)(k0 + kk) * ldw + sc] * scale : 0.f; }
    __builtin_amdgcn_s_waitcnt(0xc07f); asm volatile("" ::: "memory");
    const int c = lane & 7;
#pragma unroll
    for (int j = 0; j < 4; ++j) { const int n = (lane >> 3) + 8 * j; const float* s = scr + (8 * c) * 33 + n;
        v4u o; o.x = pk2(s[0 * 33], s[1 * 33]); o.y = pk2(s[2 * 33], s[3 * 33]); o.z = pk2(s[4 * 33], s[5 * 33]); o.w = pk2(s[6 * 33], s[7 * 33]);
        *(v4u*)(WT + (size_t)(n0 + n) * K + k0 + 8 * c) = o; }
    __builtin_amdgcn_s_waitcnt(0xc07f); asm volatile("" ::: "memory");
}
__device__ __forceinline__ void run_tr(const float* W, int K, int ldw, bf16* WT, int nout, int mode, float* scr, int gw, int NGW, int lane, int& base, float scale = 1.f) {
    const int items = (K / 64) * (nout / 32);
    int it = gw - (base % NGW); if (it < 0) it += NGW;
    for (; it < items; it += NGW) transpose_item(W, K, ldw, WT, nout, mode, scr, it, lane, scale);
    base += items;
}
__device__ __forceinline__ void cvt_rows(const float* src, bf16* dst, size_t n4, int gtid, int NGT) {
    for (size_t i = gtid; i < n4; i += NGT) { const f32x4 v = ((const f32x4*)src)[i]; v2u o; o.x = pk2(v[0], v[1]); o.y = pk2(v[2], v[3]); ((v2u*)dst)[i] = o; }
}

__device__ __forceinline__ void ln_rows(const float* V, const float* g, const float* b, bf16* xb, float* outf, int gw, int NGW, int lane) {
    f32x4 gv[4], bv[4];
#pragma unroll
    for (int j = 0; j < 4; ++j) { gv[j] = ((const f32x4*)g)[lane + 64 * j]; bv[j] = ((const f32x4*)b)[lane + 64 * j]; }
    for (int m = gw; m < T; m += NGW) {
        const f32x4* xr = (const f32x4*)(V + (size_t)m * D) + lane;
        f32x4 v[4]; float s = 0.f;
#pragma unroll
        for (int j = 0; j < 4; ++j) { v[j] = xr[64 * j]; s += (v[j][0] + v[j][1]) + (v[j][2] + v[j][3]); }
        const float mean = wave_sum(s) * (1.f / D); float s2 = 0.f;
#pragma unroll
        for (int j = 0; j < 4; ++j) { v[j] = v[j] - mean; s2 += (v[j][0] * v[j][0] + v[j][1] * v[j][1]) + (v[j][2] * v[j][2] + v[j][3] * v[j][3]); }
        const float rstd = 1.f / sqrtf(wave_sum(s2) * (1.f / D) + LN_EPS);
#pragma unroll
        for (int j = 0; j < 4; ++j) {
            const f32x4 o = v[j] * rstd * gv[j] + bv[j];
            if (xb) { v2u w; w.x = pk2(o[0], o[1]); w.y = pk2(o[2], o[3]); ((v2u*)(xb + (size_t)m * D))[lane + 64 * j] = w; }
            if (outf) ((f32x4*)(outf + (size_t)m * D))[lane + 64 * j] = o;
        }
    }
}

__device__ __forceinline__ void ssd_scan_naive(const Args& a, unsigned char* lds_raw, int unit) {
    const int tid = threadIdx.x, lane = tid & 63;
    const int b = unit >> 6, h = (unit >> 2) & 15, pq = unit & 3, g = h >> 2;
    const bf16* XBC = (const bf16*)(a.ws + WS_XBC); const float* DT = (const float*)((unsigned char*)a.out + DO_DT);
    bf16* YB = (bf16*)((unsigned char*)a.out + DO_YB);
    const float* convw = a.in[I_CONVW]; const float* convb = a.in[I_CONVB];
    const float A = -__expf(a.in[I_ALOG][h]), Dsk = a.in[I_DSKIP][h];
    float* sx = (float*)lds_raw;
    float* sB = sx + 64 * 16;
    float* sC = sB + 64 * 128;
    float* sdt = sC + 64 * 128;
    float* sy = sdt + 64;
    const int p = tid >> 5, nl = tid & 31;
    float hs0 = 0.f, hs1 = 0.f, hs2 = 0.f, hs3 = 0.f;
    for (int t0 = 0; t0 < SEQ; t0 += 64) {
        __syncthreads();
        for (int e = tid; e < 64 * 272; e += NTHR) {
            const int row = e / 272, cc = e % 272;
            const int col = cc < 16 ? (h * 64 + pq * 16 + cc) : (cc < 144 ? (1024 + g * 128 + (cc - 16)) : (1536 + g * 128 + (cc - 144)));
            const int t = t0 + row;
            float accv = convb[col];
#pragma unroll
            for (int k = 0; k < 4; ++k) { const int tt = t - 3 + k; if (tt >= 0) accv += convw[k * 2048 + col] * bf2f(XBC[((size_t)(b * SEQ + tt)) * 2048 + col]); }
            const float v = accv / (1.f + __expf(-accv));
            if (cc < 16) sx[row * 16 + cc] = v; else if (cc < 144) sB[row * 128 + (cc - 16)] = v; else sC[row * 128 + (cc - 144)] = v;
        }
        if (tid < 64) sdt[tid] = DT[(size_t)(b * SEQ + t0 + tid) * 16 + h];
        __syncthreads();
        for (int l = 0; l < 64; ++l) {
            const float dtv = sdt[l], dec = __expf(dtv * A), xr = sx[l * 16 + p], xv = xr * dtv;
            const f32x4 Bv = *(const f32x4*)(sB + l * 128 + nl * 4), Cv = *(const f32x4*)(sC + l * 128 + nl * 4);
            hs0 = hs0 * dec + xv * Bv[0]; hs1 = hs1 * dec + xv * Bv[1]; hs2 = hs2 * dec + xv * Bv[2]; hs3 = hs3 * dec + xv * Bv[3];
            float part = (hs0 * Cv[0] + hs1 * Cv[1]) + (hs2 * Cv[2] + hs3 * Cv[3]);
#pragma unroll
            for (int o = 1; o < 32; o <<= 1) part += __shfl_xor(part, o);
            if (nl == 0) sy[l * 16 + p] = part + Dsk * xr;
        }
        __syncthreads();
        for (int e = tid; e < 64 * 16; e += NTHR) { const int row = e >> 4, cc = e & 15; YB[(size_t)(b * SEQ + t0 + row) * 1024 + h * 64 + pq * 16 + cc] = (bf16)f2bf(sy[e]); }
    }
    (void)lane;
}
__device__ __forceinline__ void ssd_gate_norm(const Args& a, int gw, int NGW, int lane) {
    const bf16* YB = (const bf16*)((unsigned char*)a.out + DO_YB); bf16* ZS = (bf16*)(a.ws + WS_Z); const float* nw = a.in[I_SSDNW];
    for (int m = gw; m < T; m += NGW) {
#pragma unroll
        for (int g = 0; g < 4; ++g) {
            const size_t off = (size_t)m * 1024 + g * 256 + lane * 4;
            const v2u yw = *(const v2u*)(YB + off), zw = *(const v2u*)(ZS + off);
            float v[4] = {bflo(yw.x) * bflo(zw.x), bfhi(yw.x) * bfhi(zw.x), bflo(yw.y) * bflo(zw.y), bfhi(yw.y) * bfhi(zw.y)};
            const float ss = wave_sum((v[0] * v[0] + v[1] * v[1]) + (v[2] * v[2] + v[3] * v[3]));
            const float rs = 1.f / sqrtf(ss * (1.f / 256.f) + RMS_EPS);
            const f32x4 w = *(const f32x4*)(nw + g * 256 + lane * 4);
            v2u o; o.x = pk2(v[0] * rs * w[0], v[1] * rs * w[1]); o.y = pk2(v[2] * rs * w[2], v[3] * rs * w[3]);
            *(v2u*)(ZS + off) = o;
        }
    }
}
__device__ __forceinline__ void ckv_norm(const Args& a, int gw, int NGW, int lane) {
    const float* CKV = (const float*)((unsigned char*)a.out + DO_CKV); bf16* CKVN = (bf16*)(a.ws + WS_CKVN); const float* nw = a.in[I_KVNW];
    const f32x4 w = *(const f32x4*)(nw + lane * 4);
    for (int m = gw; m < T; m += NGW) {
        const f32x4 v = *(const f32x4*)(CKV + (size_t)m * 256 + lane * 4);
        const float ss = wave_sum((v[0] * v[0] + v[1] * v[1]) + (v[2] * v[2] + v[3] * v[3]));
        const float rs = 1.f / sqrtf(ss * (1.f / 256.f) + RMS_EPS);
        v2u o; o.x = pk2(v[0] * rs * w[0], v[1] * rs * w[1]); o.y = pk2(v[2] * rs * w[2], v[3] * rs * w[3]);
        *(v2u*)(CKVN + (size_t)m * 256 + lane * 4) = o;
    }
}

__device__ __forceinline__ unsigned f2sortable(float f) { const unsigned u = __float_as_uint(f); return (u & 0x80000000u) ? ~u : (u | 0x80000000u); }
__device__ __forceinline__ void indexer_topk_naive(const Args& a, unsigned char* lds_raw, int q) {
    const int tid = threadIdx.x, lane = tid & 63, wave = tid >> 6;
    const int b = q / SEQ, t = q % SEQ;
    const bf16* QI = (const bf16*)(a.ws + WS_QI); const bf16* KIDX = (const bf16*)(a.ws + WS_KIDX); const float* WIDX = (const float*)((unsigned char*)a.out + DO_WIDX);
    unsigned short* IDX = (unsigned short*)((unsigned char*)a.out + DO_IDX) + (size_t)q * 256;
    float* sq = (float*)lds_raw;
    float* sw = sq + 1024;
    unsigned* ssc = (unsigned*)(sw + 16);
    unsigned* wcnt = ssc + 4096;
    unsigned* misc = wcnt + 16;
    __syncthreads();
    if (t < 256) { if (tid < 256) IDX[tid] = tid <= t ? (unsigned short)tid : (unsigned short)0xFFFF; return; }
    for (int e = tid; e < 1024; e += NTHR) sq[e] = bf2f(QI[(size_t)q * 1024 + e]);
    if (tid < 16) sw[tid] = WIDX[(size_t)q * 16 + tid];
    if (tid == 0) { misc[0] = 0u; }
    __syncthreads();
    const int nvalid = t + 1;
#pragma unroll 1
    for (int jj = 0; jj < 8; ++jj) {
        const int s = tid + NTHR * jj;
        unsigned u = 0u;
        if (s < nvalid) {
            float kf[64];
            const v4u* kp = (const v4u*)(KIDX + (size_t)(b * SEQ + s) * 64);
#pragma unroll
            for (int c = 0; c < 8; ++c) { const v4u w = kp[c]; kf[8 * c] = bflo(w.x); kf[8 * c + 1] = bfhi(w.x); kf[8 * c + 2] = bflo(w.y); kf[8 * c + 3] = bfhi(w.y); kf[8 * c + 4] = bflo(w.z); kf[8 * c + 5] = bfhi(w.z); kf[8 * c + 6] = bflo(w.w); kf[8 * c + 7] = bfhi(w.w); }
            float sc = 0.f;
#pragma unroll 1
            for (int hh = 0; hh < 16; ++hh) {
                float d0 = 0.f, d1 = 0.f;
#pragma unroll
                for (int d = 0; d < 64; d += 4) { const f32x4 qv = *(const f32x4*)(sq + hh * 64 + d); d0 += qv[0] * kf[d] + qv[2] * kf[d + 2]; d1 += qv[1] * kf[d + 1] + qv[3] * kf[d + 3]; }
                sc += sw[hh] * fmaxf(d0 + d1, 0.f);
            }
            u = f2sortable(sc);
        }
        ssc[s] = u;
    }
    __syncthreads();
    unsigned tau = 0u;
    for (int bit = 31; bit >= 0; --bit) {
        const unsigned cand = tau | (1u << bit);
        unsigned c = 0;
#pragma unroll
        for (int jj = 0; jj < 8; ++jj) c += (unsigned)__popcll(__ballot(ssc[tid + NTHR * jj] >= cand));
        unsigned* wc_ = wcnt + (bit & 1) * 8;
        if (lane == 0) wc_[wave] = c;
        __syncthreads();
        unsigned tot = 0;
#pragma unroll
        for (int w = 0; w < 8; ++w) tot += wc_[w];
        if (tot >= 256u) tau = cand;
    }
    unsigned cgt = 0;
    {
        unsigned c = 0;
#pragma unroll
        for (int jj = 0; jj < 8; ++jj) c += (unsigned)__popcll(__ballot(ssc[tid + NTHR * jj] > tau));
        __syncthreads();
        if (lane == 0) wcnt[wave] = c;
        __syncthreads();
#pragma unroll
        for (int w = 0; w < 8; ++w) cgt += wcnt[w];
    }
    const unsigned need_eq = 256u - cgt;
    unsigned gt_run = 0, eq_run = 0;
    for (int jj = 0; jj < 8; ++jj) {
        const int s = tid + NTHR * jj; const unsigned u = ssc[s];
        const bool gt = (u > tau), eq = (u == tau);
        const unsigned long long bg = __ballot(gt), be = __ballot(eq), lm = (1ull << lane) - 1ull;
        const unsigned ing = (unsigned)__popcll(bg & lm), ine = (unsigned)__popcll(be & lm);
        __syncthreads();
        if (lane == 0) wcnt[wave] = (unsigned)__popcll(bg) | ((unsigned)__popcll(be) << 16);
        __syncthreads();
        unsigned bgt = gt_run, beq = eq_run, allg = 0, alle = 0;
#pragma unroll
        for (int w = 0; w < 8; ++w) { const unsigned cw = wcnt[w]; if (w < wave) { bgt += cw & 0xffffu; beq += cw >> 16; } allg += cw & 0xffffu; alle += cw >> 16; }
        if (gt) IDX[bgt + ing] = (unsigned short)s;
        if (eq) { const unsigned r = beq + ine; if (r < need_eq) IDX[cgt + r] = (unsigned short)s; }
        gt_run += allg; eq_run += alle;
    }
}

__device__ __forceinline__ void sparse_attn_naive(const Args& a, unsigned char* lds_raw, int q) {
    const int tid = threadIdx.x, lane = tid & 63, wave = tid >> 6;
    const int b = q / SEQ, t = q % SEQ;
    bf16* Qb = (bf16*)(a.ws + WS_Q); const bf16* CKVN = (const bf16*)(a.ws + WS_CKVN);
    const unsigned short* IDX = (const unsigned short*)((unsigned char*)a.out + DO_IDX) + (size_t)q * 256;
    const float* wuk = a.in[I_WUK]; const float* wuv = a.in[I_WUV];
    float* sq = (float*)lds_raw;
    float* sql = sq + 1024;
    float* ss = sql + 4096;
    float* so = ss + 4096;
    int* sidx = (int*)(so + 4096);
    __syncthreads();
    for (int e = tid; e < 1024; e += NTHR) sq[e] = bf2f(Qb[(size_t)q * 1024 + e]);
    if (tid < 256) { const int id = IDX[tid]; sidx[tid] = (id == 0xFFFF || id > t) ? -1 : id; }
    __syncthreads();
    {
        const int h = tid >> 5, r8 = (tid & 31) * 8;
        float acc[8] = {0.f, 0.f, 0.f, 0.f, 0.f, 0.f, 0.f, 0.f};
#pragma unroll 2
        for (int d = 0; d < 64; ++d) {
            const float qd = sq[h * 64 + d]; const float* wp = wuk + ((size_t)(h * 64 + d)) * 256 + r8;
            const f32x4 w0 = *(const f32x4*)wp, w1 = *(const f32x4*)(wp + 4);
#pragma unroll
            for (int i = 0; i < 4; ++i) { acc[i] += qd * w0[i]; acc[4 + i] += qd * w1[i]; }
        }
#pragma unroll
        for (int i = 0; i < 8; ++i) sql[h * 256 + r8 + i] = acc[i] * 0.125f;
    }
    __syncthreads();
    {
        const int k = tid >> 1, hh = tid & 1, id = sidx[k];
        float acc[8] = {0.f, 0.f, 0.f, 0.f, 0.f, 0.f, 0.f, 0.f};
        if (id >= 0) {
            const v4u* cp = (const v4u*)(CKVN + (size_t)(b * SEQ + id) * 256);
#pragma unroll 1
            for (int r0 = 0; r0 < 256; r0 += 8) {
                const v4u w = cp[r0 >> 3];
                const float c[8] = {bflo(w.x), bfhi(w.x), bflo(w.y), bfhi(w.y), bflo(w.z), bfhi(w.z), bflo(w.w), bfhi(w.w)};
#pragma unroll
                for (int hl = 0; hl < 8; ++hl) {
                    const float* qp = sql + (hh * 8 + hl) * 256 + r0;
                    const f32x4 q0 = *(const f32x4*)qp, q1 = *(const f32x4*)(qp + 4);
                    acc[hl] += (q0[0] * c[0] + q0[1] * c[1]) + (q0[2] * c[2] + q0[3] * c[3]) + (q1[0] * c[4] + q1[1] * c[5]) + (q1[2] * c[6] + q1[3] * c[7]);
                }
            }
        }
#pragma unroll
        for (int hl = 0; hl < 8; ++hl) {
            const int h = hh * 8 + hl; const float slope = exp2f(-0.5f * (float)(h + 1));
            ss[h * 256 + k] = id >= 0 ? acc[hl] - slope * (float)(t - id) : -INFINITY;
        }
    }
    __syncthreads();
    {
#pragma unroll
        for (int hl = 0; hl < 2; ++hl) {
            float* row = ss + (wave * 2 + hl) * 256;
            float v[4]; float mx = -INFINITY;
#pragma unroll
            for (int i = 0; i < 4; ++i) { v[i] = row[lane + 64 * i]; mx = fmaxf(mx, v[i]); }
            mx = wave_max(mx);
            float sum = 0.f;
#pragma unroll
            for (int i = 0; i < 4; ++i) { v[i] = __expf(v[i] - mx); sum += v[i]; }
            sum = wave_sum(sum);
            const float inv = 1.f / sum;
#pragma unroll
            for (int i = 0; i < 4; ++i) row[lane + 64 * i] = v[i] * inv;
        }
    }
    __syncthreads();
    {
        const int r = tid & 255, hh = tid >> 8;
        float acc[8] = {0.f, 0.f, 0.f, 0.f, 0.f, 0.f, 0.f, 0.f};
#pragma unroll 2
        for (int k = 0; k < 256; ++k) {
            const int id = sidx[k]; if (id < 0) continue;
            const float c = bf2f(CKVN[(size_t)(b * SEQ + id) * 256 + r]);
#pragma unroll
            for (int hl = 0; hl < 8; ++hl) acc[hl] += ss[(hh * 8 + hl) * 256 + k] * c;
        }
#pragma unroll
        for (int hl = 0; hl < 8; ++hl) so[(hh * 8 + hl) * 256 + r] = acc[hl];
    }
    __syncthreads();
    {
        const int h = tid >> 5, d2 = (tid & 31) * 2;
        float a0 = 0.f, a1 = 0.f;
#pragma unroll 4
        for (int r = 0; r < 256; ++r) { const float o = so[h * 256 + r]; const f32x2 w = *(const f32x2*)(wuv + ((size_t)(h * 256 + r)) * 64 + d2); a0 += o * w[0]; a1 += o * w[1]; }
        *(unsigned*)(Qb + (size_t)q * 1024 + h * 64 + d2) = pk2(a0, a1);
    }
}

__device__ __forceinline__ void mem_attn_naive(const Args& a, unsigned char* lds_raw, int q) {
    const int tid = threadIdx.x, lane = tid & 63, wave = tid >> 6;
    const int b = q / SEQ;
    bf16* QM = (bf16*)(a.ws + WS_Z); const bf16* KVM = (const bf16*)(a.ws + WS_KVM);
    float* sq = (float*)lds_raw;
    float* ss = sq + 1024;
    __syncthreads();
    for (int e = tid; e < 1024; e += NTHR) sq[e] = bf2f(QM[(size_t)q * 1024 + e]);
    __syncthreads();
    {
        const int m = tid & 255, hp = tid >> 8;
#pragma unroll
        for (int hl = 0; hl < 2; ++hl) {
            const int hd = hp * 2 + hl;
            const v4u* kp = (const v4u*)(KVM + (size_t)(b * MEML + m) * 2048 + hd * 256);
            float acc = 0.f;
            for (int c = 0; c < 32; ++c) {
                const v4u w = kp[c]; const float* qp = sq + hd * 256 + c * 8;
                const f32x4 q0 = *(const f32x4*)qp, q1 = *(const f32x4*)(qp + 4);
                acc += (q0[0] * bflo(w.x) + q0[1] * bfhi(w.x)) + (q0[2] * bflo(w.y) + q0[3] * bfhi(w.y)) + (q1[0] * bflo(w.z) + q1[1] * bfhi(w.z)) + (q1[2] * bflo(w.w) + q1[3] * bfhi(w.w));
            }
            ss[hd * 256 + m] = acc * 0.0625f;
        }
    }
    __syncthreads();
    if (wave < 4) {
        float* row = ss + wave * 256;
        float v[4]; float mx = -INFINITY;
#pragma unroll
        for (int i = 0; i < 4; ++i) { v[i] = row[lane + 64 * i]; mx = fmaxf(mx, v[i]); }
        mx = wave_max(mx);
        float sum = 0.f;
#pragma unroll
        for (int i = 0; i < 4; ++i) { v[i] = __expf(v[i] - mx); sum += v[i]; }
        sum = wave_sum(sum);
        const float inv = 1.f / sum;
#pragma unroll
        for (int i = 0; i < 4; ++i) row[lane + 64 * i] = v[i] * inv;
    }
    __syncthreads();
    {
        const int c = tid * 2, hd = c >> 8;
        float a0 = 0.f, a1 = 0.f;
        for (int m = 0; m < 256; ++m) { const float p = ss[hd * 256 + m]; const unsigned w = *(const unsigned*)(KVM + (size_t)(b * MEML + m) * 2048 + 1024 + c); a0 += p * bflo(w); a1 += p * bfhi(w); }
        *(unsigned*)(QM + (size_t)q * 1024 + c) = pk2(a0, a1);
    }
}

typedef short bf16x8_t __attribute__((ext_vector_type(8)));
typedef float f32x16_t __attribute__((ext_vector_type(16)));
#define IDX_GRP_BYTES 32768
__device__ __forceinline__ unsigned half_sum_u32(unsigned v) {
#pragma unroll
    for (int o = 1; o < 32; o <<= 1) v += (unsigned)__shfl_xor((int)v, o);
    return v;
}
__device__ __forceinline__ void indexer_task(const Args& a, LAS unsigned char* lds, int b, int blk) {
    const int tid = threadIdx.x, lane = tid & 63, wave = __builtin_amdgcn_readfirstlane(tid >> 6);
    int r32 = lane & 31; const int hi = lane >> 5;
    asm volatile("" : "+v"(r32));
    const int t0 = blk * 16, tq = t0 + 2 * wave + hi;
    const bf16* QI = (const bf16*)(a.ws + WS_QI); const bf16* KIDX = (const bf16*)(a.ws + WS_KIDX); const float* WIDX = (const float*)((unsigned char*)a.out + DO_WIDX);
    unsigned short* IDXq = (unsigned short*)((unsigned char*)a.out + DO_IDX) + (size_t)(b * SEQ + tq) * 256;
    if (blk < 16) {
#pragma unroll
        for (int j = 0; j < 8; ++j) { const int k = r32 + 32 * j; IDXq[k] = k <= tq ? (unsigned short)k : (unsigned short)0xFFFF; }
        return;
    }
    const int ntiles = ((t0 + 15) >> 5) + 1, ngroups = (ntiles + 7) >> 3;
    bf16x8_t af[4];
    { const int qsel = (r32 >> 2) & 1, head = (r32 & 3) + 4 * (r32 >> 3);
      const bf16* qp = QI + (size_t)(b * SEQ + t0 + 2 * wave + qsel) * 1024 + head * 64 + hi * 8;
#pragma unroll
      for (int ks = 0; ks < 4; ++ks) af[ks] = *(const bf16x8_t*)(qp + ks * 16); }
    float w[16];
    { const f32x4* wp = (const f32x4*)(WIDX + (size_t)(b * SEQ + tq) * 16);
#pragma unroll
      for (int j = 0; j < 4; ++j) { const f32x4 v = wp[j]; w[4 * j] = v[0]; w[4 * j + 1] = v[1]; w[4 * j + 2] = v[2]; w[4 * j + 3] = v[3]; } }
    int srcoff[4];
#pragma unroll
    for (int j = 0; j < 4; ++j) { const int sg = 64 * j + lane, rho = sg >> 3, p = sg & 7, key = ((rho & 1) << 4) | (rho >> 1), c = p ^ (key & 7); srcoff[j] = key * 64 + c * 8; }
    int rdoff[4];
    { const int key = r32, rho = ((key & 15) << 1) | (key >> 4);
#pragma unroll
      for (int ks = 0; ks < 4; ++ks) rdoff[ks] = (rho * 8 + ((2 * ks + hi) ^ (key & 7))) * 16; }
    const bf16* kb = KIDX + (size_t)b * SEQ * 64;
#define IDX_DMA(grp, buf) do { const bf16* tb_ = kb + (size_t)(8 * (grp) + wave) * 32 * 64; _Pragma("unroll") for (int j_ = 0; j_ < 4; ++j_) \
        __builtin_amdgcn_global_load_lds((const unsigned*)(tb_ + srcoff[j_]), (LAS unsigned*)(lds + (buf) * IDX_GRP_BYTES + wave * 4096 + j_ * 1024), 16, 0, 0); } while (0)
    unsigned sc[128];
#pragma unroll
    for (int i = 0; i < 128; ++i) sc[i] = 0u;
    IDX_DMA(0, 0);
#pragma unroll
    for (int grp = 0; grp < 16; ++grp) {
        if (grp < ngroups) {
            asm volatile("s_waitcnt vmcnt(0)" ::: "memory");
            __builtin_amdgcn_s_barrier();
            asm volatile("" ::: "memory");
            if (grp + 1 < ngroups) IDX_DMA(grp + 1, (grp + 1) & 1);
#pragma unroll
            for (int j = 0; j < 8; ++j) {
                const LAS unsigned char* tb = lds + (grp & 1) * IDX_GRP_BYTES + j * 4096;
                bf16x8_t bfr[4];
#pragma unroll
                for (int ks = 0; ks < 4; ++ks) bfr[ks] = *(const LAS bf16x8_t*)(tb + rdoff[ks]);
                f32x16_t acc = {0.f, 0.f, 0.f, 0.f, 0.f, 0.f, 0.f, 0.f, 0.f, 0.f, 0.f, 0.f, 0.f, 0.f, 0.f, 0.f};
#pragma unroll
                for (int ks = 0; ks < 4; ++ks) acc = __builtin_amdgcn_mfma_f32_32x32x16_bf16(af[ks], bfr[ks], acc, 0, 0, 0);
                f32x2 s2 = {0.f, 0.f};
#pragma unroll
                for (int h = 0; h < 16; h += 2) { f32x2 rl; rl[0] = __int_as_float(max(__float_as_int(acc[h]), 0)); rl[1] = __int_as_float(max(__float_as_int(acc[h + 1]), 0));
                    const f32x2 ww = {w[h], w[h + 1]}; s2 = __builtin_elementwise_fma(ww, rl, s2); }
                const float s = s2[0] + s2[1];
                const int gkey = 32 * (8 * grp + j) + r32;
                unsigned u_ = gkey <= tq ? f2sortable(s) : 0u;
                asm volatile("" : "+v"(u_));
                sc[8 * grp + j] = u_;
                __builtin_amdgcn_sched_barrier(0);
            }
        }
    }
#undef IDX_DMA
    unsigned tau = 0u; bool done = false;
    for (int bit = 31; bit >= 0; --bit) {
        const unsigned cand = tau | (1u << bit);
        unsigned cnt = 0;
#pragma unroll
        for (int g8 = 0; g8 < 8; ++g8) {
            if (g8 * 16 < ntiles) {
#pragma unroll
                for (int i = 0; i < 16; ++i) cnt += (sc[g8 * 16 + i] >= cand) ? 1u : 0u;
            }
        }
        cnt = half_sum_u32(cnt);
        if (!done) { if (cnt >= 256u) tau = cand; if (cnt == 256u) done = true; }
        if (__ballot(done) == ~0ull) break;
    }
    unsigned cgt = 0;
#pragma unroll
    for (int g8 = 0; g8 < 8; ++g8) {
        if (g8 * 16 < ntiles) {
#pragma unroll
            for (int i = 0; i < 16; ++i) cgt += (sc[g8 * 16 + i] > tau) ? 1u : 0u;
        }
    }
    cgt = half_sum_u32(cgt);
    int r32c = r32; asm volatile("" : "+v"(r32c));
    const unsigned need_eq = 256u - cgt, ltm = (1u << r32c) - 1u;
    unsigned bg = 0u, be = 0u;
#pragma unroll
    for (int g8 = 0; g8 < 8; ++g8) {
        if (g8 * 16 < ntiles) {
#pragma unroll
            for (int i = 0; i < 16; ++i) {
                const unsigned u = sc[g8 * 16 + i]; const bool gt = u > tau, eq = u == tau;
                const unsigned long long mg = __ballot(gt), me = __ballot(eq);
                const unsigned hg = hi ? (unsigned)(mg >> 32) : (unsigned)mg, he = hi ? (unsigned)(me >> 32) : (unsigned)me;
                const unsigned short key = (unsigned short)(32 * (g8 * 16 + i) + r32c);
                if (gt) IDXq[bg + __popc(hg & ltm)] = key;
                if (eq) { const unsigned rk = be + __popc(he & ltm); if (rk < need_eq) IDXq[cgt + rk] = key; }
                bg += __popc(hg); be += __popc(he);
            }
        }
    }
}

typedef float f32x4_t __attribute__((ext_vector_type(4)));
typedef short s16x4_t __attribute__((ext_vector_type(4)));
constexpr int AT_SIDX = 131072, AT_LDS_END = AT_SIDX + 8 * 512;
__device__ __forceinline__ s16x4_t lds_tr16(const LAS unsigned char* p) { return __builtin_bit_cast(s16x4_t, __builtin_amdgcn_ds_read_tr16_b64_v4i16((LAS s16x4_t*)p)); }
__device__ __forceinline__ unsigned pkbf(float lo, float hi) { return pg8::cvt_pk_bf16(lo, hi); }
__device__ __forceinline__ void attn_batch(const Args& a, LAS unsigned char* lds, int row0  ) {
    const int tid = threadIdx.x, lane = tid & 63, wave = __builtin_amdgcn_readfirstlane(tid >> 6);
    const int n16 = lane & 15, g = lane >> 4;
    bf16* Qb = (bf16*)(a.ws + WS_Q); const bf16* CKVN = (const bf16*)(a.ws + WS_CKVN);
    const bf16* WUKT = (const bf16*)(a.ws + WS_WUK); const bf16* WUVT = WUKT + 16 * 256 * 64;
    const unsigned short* IDXg = (const unsigned short*)((unsigned char*)a.out + DO_IDX);
#pragma unroll 1
    for (int hl = 0; hl < 2; ++hl) {
        const int h = 2 * wave + hl;
        bf16x8_t qa[2];
        { const bf16* qp = Qb + (size_t)(row0 + (n16 & 7)) * 1024 + h * 64 + 8 * g;
          qa[0] = *(const bf16x8_t*)qp; qa[1] = *(const bf16x8_t*)(qp + 32); }
        const bf16* wp = WUKT + (size_t)h * 256 * 64 + (size_t)n16 * 64 + 8 * g;
#pragma unroll 4
        for (int nt = 0; nt < 16; ++nt) {
            const bf16x8_t b0 = *(const bf16x8_t*)(wp + nt * 16 * 64), b1 = *(const bf16x8_t*)(wp + nt * 16 * 64 + 32);
            f32x4_t c = {0.f, 0.f, 0.f, 0.f};
            c = __builtin_amdgcn_mfma_f32_16x16x32_bf16(qa[0], b0, c, 0, 0, 0);
            c = __builtin_amdgcn_mfma_f32_16x16x32_bf16(qa[1], b1, c, 0, 0, 0);
            if (g < 2) {
#pragma unroll
                for (int i = 0; i < 4; ++i) *(LAS unsigned short*)(lds + (size_t)((4 * g + i) * 16 + h) * 512 + (16 * nt + n16) * 2) = (unsigned short)f2bf(c[i]);
            }
        }
    }
    const int qrow = row0 + wave, t = qrow & (SEQ - 1), rowb = qrow - t;
    LAS unsigned char* sidx = lds + AT_SIDX + wave * 512;
    *(LAS v2u*)(sidx + lane * 8) = *(const v2u*)(IDXg + (size_t)qrow * 256 + lane * 4);
    asm volatile("s_waitcnt vmcnt(0) lgkmcnt(0)" ::: "memory"); __builtin_amdgcn_s_barrier(); asm volatile("" ::: "memory");
    bf16x8_t qlf[8];
#pragma unroll
    for (int ks = 0; ks < 8; ++ks) qlf[ks] = *(const LAS bf16x8_t*)(lds + (size_t)(wave * 16 + n16) * 512 + (32 * ks + 8 * g) * 2);
    asm volatile("s_waitcnt lgkmcnt(0)" ::: "memory"); __builtin_amdgcn_s_barrier(); asm volatile("" ::: "memory");
    LAS unsigned char* buf = lds + wave * 16384;
    const float slope2 = exp2f(-0.5f * (float)(n16 + 1)) * 1.44269504f;
    f32x4_t O[16];
#pragma unroll
    for (int nt = 0; nt < 16; ++nt) O[nt] = (f32x4_t){0.f, 0.f, 0.f, 0.f};
    float m_run = -INFINITY, l_run = 0.f;
    const int kap = 8 * (n16 >> 2) + (n16 & 3), fk = ((kap & 3) << 1) | (((kap >> 3) & 1) << 3);
    const int tkey = 8 * g + (n16 >> 2), tf = ((tkey & 3) << 1) | (((tkey >> 3) & 1) << 3), tp = n16 & 3;
#pragma unroll 1
    for (int ch = 0; ch < 8; ++ch) {
#pragma unroll
        for (int j = 0; j < 16; ++j) {
            const int key = 2 * j + (lane >> 5), fkey = ((key & 3) << 1) | (((key >> 3) & 1) << 3);
            int id = *(const LAS unsigned short*)(sidx + (32 * ch + key) * 2); if (id > t) id = 0;
            const bf16* src = CKVN + (size_t)(rowb + id) * 256 + (((lane & 31) ^ fkey) * 8);
            __builtin_amdgcn_global_load_lds((const unsigned*)src, (LAS unsigned*)(buf + j * 1024), 16, 0, 0);
        }
        const v4u idw = *(const LAS v4u*)(sidx + (32 * ch + 8 * g) * 2);
        asm volatile("s_waitcnt vmcnt(0) lgkmcnt(0)" ::: "memory");
        f32x4_t sa = {0.f, 0.f, 0.f, 0.f}, sb = {0.f, 0.f, 0.f, 0.f};
#pragma unroll
        for (int ks = 0; ks < 8; ++ks) {
            const int slot = (4 * ks + g) ^ fk;
            const bf16x8_t ca = *(const LAS bf16x8_t*)(buf + kap * 512 + slot * 16), cb = *(const LAS bf16x8_t*)(buf + (kap + 4) * 512 + slot * 16);
            sa = __builtin_amdgcn_mfma_f32_16x16x32_bf16(ca, qlf[ks], sa, 0, 0, 0);
            sb = __builtin_amdgcn_mfma_f32_16x16x32_bf16(cb, qlf[ks], sb, 0, 0, 0);
        }
        float s[8];
        {
            const unsigned iw[4] = {idw.x, idw.y, idw.z, idw.w};
#pragma unroll
            for (int j = 0; j < 8; ++j) {
                const int id = (int)((iw[j >> 1] >> (16 * (j & 1))) & 0xffffu);
                const float sv = (j < 4 ? sa[j & 3] : sb[j & 3]) * 1.44269504f - slope2 * (float)(t - id);
                s[j] = id <= t ? sv : -INFINITY;
            }
        }
        float mx = fmaxf(fmaxf(fmaxf(s[0], s[1]), fmaxf(s[2], s[3])), fmaxf(fmaxf(s[4], s[5]), fmaxf(s[6], s[7])));
        mx = fmaxf(mx, __shfl_xor(mx, 16)); mx = fmaxf(mx, __shfl_xor(mx, 32));
        const float m_new = fmaxf(m_run, mx);
        const float m_use = m_new == -INFINITY ? 0.f : m_new;
        const float alpha = exp2f(m_run - m_use);
        float p[8]; float ps = 0.f;
#pragma unroll
        for (int j = 0; j < 8; ++j) { p[j] = exp2f(s[j] - m_use); ps += p[j]; }
        l_run = l_run * alpha + ps; m_run = m_new;
        bf16x8_t pf;
        { v4u pw; pw.x = pkbf(p[0], p[1]); pw.y = pkbf(p[2], p[3]); pw.z = pkbf(p[4], p[5]); pw.w = pkbf(p[6], p[7]); pf = __builtin_bit_cast(bf16x8_t, pw); }
        float al[4];
#pragma unroll
        for (int i = 0; i < 4; ++i) al[i] = __shfl(alpha, 4 * g + i);
#pragma unroll
        for (int nt = 0; nt < 16; ++nt) { O[nt][0] *= al[0]; O[nt][1] *= al[1]; O[nt][2] *= al[2]; O[nt][3] *= al[3]; }
#pragma unroll
        for (int nt = 0; nt < 16; ++nt) {
            const LAS unsigned char* tpa = buf + tkey * 512 + (((2 * nt + (tp >> 1)) ^ tf) * 16) + 8 * (tp & 1);
            const s16x4_t v0 = lds_tr16(tpa), v1 = lds_tr16(tpa + 4 * 512);
            const bf16x8_t vb = {v0[0], v0[1], v0[2], v0[3], v1[0], v1[1], v1[2], v1[3]};
            O[nt] = __builtin_amdgcn_mfma_f32_16x16x32_bf16(pf, vb, O[nt], 0, 0, 0);
        }
        asm volatile("s_waitcnt lgkmcnt(0)" ::: "memory");
    }
    float lt = l_run + __shfl_xor(l_run, 16); lt += __shfl_xor(lt, 32);
    const float inv = 1.f / lt;
    float iv[4];
#pragma unroll
    for (int i = 0; i < 4; ++i) iv[i] = __shfl(inv, 4 * g + i);
    __builtin_amdgcn_s_barrier(); asm volatile("" ::: "memory");
#pragma unroll
    for (int nt = 0; nt < 16; ++nt)
#pragma unroll
        for (int i = 0; i < 4; ++i) *(LAS unsigned short*)(lds + (size_t)(wave * 16 + 4 * g + i) * 512 + (16 * nt + n16) * 2) = (unsigned short)f2bf(O[nt][i] * iv[i]);
    asm volatile("s_waitcnt lgkmcnt(0)" ::: "memory"); __builtin_amdgcn_s_barrier(); asm volatile("" ::: "memory");
#pragma unroll 1
    for (int hl = 0; hl < 2; ++hl) {
        const int h = 2 * wave + hl;
        bf16x8_t oa[8];
#pragma unroll
        for (int ks = 0; ks < 8; ++ks) oa[ks] = *(const LAS bf16x8_t*)(lds + (size_t)((n16 & 7) * 16 + h) * 512 + (32 * ks + 8 * g) * 2);
        const bf16* wp = WUVT + (size_t)h * 64 * 256 + (size_t)n16 * 256 + 8 * g;
#pragma unroll
        for (int nt = 0; nt < 4; ++nt) {
            f32x4_t c = {0.f, 0.f, 0.f, 0.f};
#pragma unroll
            for (int ks = 0; ks < 8; ++ks) { const bf16x8_t bw = *(const bf16x8_t*)(wp + nt * 16 * 256 + ks * 32); c = __builtin_amdgcn_mfma_f32_16x16x32_bf16(oa[ks], bw, c, 0, 0, 0); }
            if (g < 2) {
#pragma unroll
                for (int i = 0; i < 4; ++i) Qb[(size_t)(row0 + 4 * g + i) * 1024 + h * 64 + 16 * nt + n16] = (bf16)f2bf(c[i]);
            }
        }
    }
    asm volatile("s_waitcnt lgkmcnt(0)" ::: "memory"); __builtin_amdgcn_s_barrier(); asm volatile("" ::: "memory");
}

__device__ __forceinline__ void memattn_unit(const Args& a, LAS unsigned char* lds, int b, int hd, int qblk) {
    const int tid = threadIdx.x, lane = tid & 63, wave = __builtin_amdgcn_readfirstlane(tid >> 6);
    const int n16 = lane & 15, g = lane >> 4;
    bf16* QM = (bf16*)(a.ws + WS_Z); const bf16* KVM = (const bf16*)(a.ws + WS_KVM);
    const int row0 = b * SEQ + qblk * 128 + wave * 16;
    bf16x8_t qf[8];
    { const bf16* qp = QM + (size_t)(row0 + n16) * 1024 + hd * 256 + 8 * g;
#pragma unroll
      for (int ks = 0; ks < 8; ++ks) qf[ks] = *(const bf16x8_t*)(qp + 32 * ks); }
    const bf16* kbase = KVM + (size_t)b * MEML * 2048 + hd * 256;
    int soff[2];
#pragma unroll
    for (int jj = 0; jj < 2; ++jj) { const int j = wave + 8 * jj, key = 2 * j + (lane >> 5), fkey = ((key & 3) << 1) | (((key >> 3) & 1) << 3); soff[jj] = key * 2048 + (((lane & 31) ^ fkey) * 8); }
#define MA_DMA(ch, bufi) do { const bf16* cb_ = kbase + (size_t)(32 * (ch)) * 2048; _Pragma("unroll") for (int jj_ = 0; jj_ < 2; ++jj_) { \
        __builtin_amdgcn_global_load_lds((const unsigned*)(cb_ + soff[jj_]), (LAS unsigned*)(lds + (bufi) * 32768 + (wave + 8 * jj_) * 1024), 16, 0, 0); \
        __builtin_amdgcn_global_load_lds((const unsigned*)(cb_ + 1024 + soff[jj_]), (LAS unsigned*)(lds + (bufi) * 32768 + 16384 + (wave + 8 * jj_) * 1024), 16, 0, 0); } } while (0)
    f32x4_t O[16];
#pragma unroll
    for (int nt = 0; nt < 16; ++nt) O[nt] = (f32x4_t){0.f, 0.f, 0.f, 0.f};
    float m_run = -INFINITY, l_run = 0.f;
    const int kap = 8 * (n16 >> 2) + (n16 & 3), fk = ((kap & 3) << 1) | (((kap >> 3) & 1) << 3);
    const int tkey = 8 * g + (n16 >> 2), tf = ((tkey & 3) << 1) | (((tkey >> 3) & 1) << 3), tp = n16 & 3;
    asm volatile("s_waitcnt vmcnt(0)" ::: "memory");
    __builtin_amdgcn_s_barrier();
    MA_DMA(0, 0);
#pragma unroll 1
    for (int ch = 0; ch < 8; ++ch) {
        asm volatile("s_waitcnt vmcnt(0)" ::: "memory");
        __builtin_amdgcn_s_barrier();
        asm volatile("" ::: "memory");
        if (ch + 1 < 8) MA_DMA(ch + 1, (ch + 1) & 1);
        const LAS unsigned char* kbuf = lds + (ch & 1) * 32768; const LAS unsigned char* vbuf = kbuf + 16384;
        f32x4_t sa = {0.f, 0.f, 0.f, 0.f}, sb = {0.f, 0.f, 0.f, 0.f};
#pragma unroll
        for (int ks = 0; ks < 8; ++ks) {
            const int slot = (4 * ks + g) ^ fk;
            const bf16x8_t ca = *(const LAS bf16x8_t*)(kbuf + kap * 512 + slot * 16), cb = *(const LAS bf16x8_t*)(kbuf + (kap + 4) * 512 + slot * 16);
            sa = __builtin_amdgcn_mfma_f32_16x16x32_bf16(ca, qf[ks], sa, 0, 0, 0);
            sb = __builtin_amdgcn_mfma_f32_16x16x32_bf16(cb, qf[ks], sb, 0, 0, 0);
        }
        float s[8];
#pragma unroll
        for (int j = 0; j < 8; ++j) s[j] = (j < 4 ? sa[j & 3] : sb[j & 3]) * (0.0625f * 1.44269504f);
        float mx = fmaxf(fmaxf(fmaxf(s[0], s[1]), fmaxf(s[2], s[3])), fmaxf(fmaxf(s[4], s[5]), fmaxf(s[6], s[7])));
        mx = fmaxf(mx, __shfl_xor(mx, 16)); mx = fmaxf(mx, __shfl_xor(mx, 32));
        const float m_new = fmaxf(m_run, mx);
        const float alpha = exp2f(m_run - m_new);
        float p[8]; float ps = 0.f;
#pragma unroll
        for (int j = 0; j < 8; ++j) { p[j] = exp2f(s[j] - m_new); ps += p[j]; }
        l_run = l_run * alpha + ps; m_run = m_new;
        bf16x8_t pf;
        { v4u pw; pw.x = pkbf(p[0], p[1]); pw.y = pkbf(p[2], p[3]); pw.z = pkbf(p[4], p[5]); pw.w = pkbf(p[6], p[7]); pf = __builtin_bit_cast(bf16x8_t, pw); }
        float al[4];
#pragma unroll
        for (int i = 0; i < 4; ++i) al[i] = __shfl(alpha, 4 * g + i);
#pragma unroll
        for (int nt = 0; nt < 16; ++nt) { O[nt][0] *= al[0]; O[nt][1] *= al[1]; O[nt][2] *= al[2]; O[nt][3] *= al[3]; }
#pragma unroll
        for (int nt = 0; nt < 16; ++nt) {
            const LAS unsigned char* tpa = vbuf + tkey * 512 + (((2 * nt + (tp >> 1)) ^ tf) * 16) + 8 * (tp & 1);
            const s16x4_t v0 = lds_tr16(tpa), v1 = lds_tr16(tpa + 4 * 512);
            const bf16x8_t vb = {v0[0], v0[1], v0[2], v0[3], v1[0], v1[1], v1[2], v1[3]};
            O[nt] = __builtin_amdgcn_mfma_f32_16x16x32_bf16(pf, vb, O[nt], 0, 0, 0);
        }
        asm volatile("s_waitcnt lgkmcnt(0)" ::: "memory");
    }
#undef MA_DMA
    float lt = l_run + __shfl_xor(l_run, 16); lt += __shfl_xor(lt, 32);
    const float inv = 1.f / lt;
    float iv[4];
#pragma unroll
    for (int i = 0; i < 4; ++i) iv[i] = __shfl(inv, 4 * g + i);
#pragma unroll
    for (int nt = 0; nt < 16; ++nt)
#pragma unroll
        for (int i = 0; i < 4; ++i) QM[(size_t)(row0 + 4 * g + i) * 1024 + hd * 256 + 16 * nt + n16] = (bf16)f2bf(O[nt][i] * iv[i]);
}

constexpr int SD_X = 0, SD_B = 65536, SD_C = 98304, SD_ACS = 131072, SD_DT = SD_ACS + 2048, SD_W = SD_DT + 2048, SD_END = SD_W + 2048;
constexpr size_t DO_ST = 26 * MiB, DO_DEC = 58 * MiB;
__device__ __forceinline__ int sdf(int row) { return ((row & 3) << 1) | (((row >> 3) & 1) << 3); }
__device__ __forceinline__ void ssd_conv_fill(const Args& a, LAS unsigned char* lds, int b, int c, int g, bool withC) {
    int tid = threadIdx.x; asm volatile("" : "+v"(tid));
    const int chunk = tid & 63, strip = tid >> 6;
    if (!withC && chunk >= 48) return;
    int col, img, rowb, ci;
    if (chunk < 32) { col = g * 256 + chunk * 8; img = SD_X; rowb = 512; ci = chunk; }
    else if (chunk < 48) { col = 1024 + g * 128 + (chunk - 32) * 8; img = SD_B; rowb = 256; ci = chunk - 32; }
    else { col = 1536 + g * 128 + (chunk - 48) * 8; img = SD_C; rowb = 256; ci = chunk - 48; }
    const float* cw = a.in[I_CONVW] + col; const float* cbp = a.in[I_CONVB] + col;
    float w0[8], w1[8], w2[8], w3[8], bs[8];
#pragma unroll
    for (int e = 0; e < 8; e += 4) {
        const f32x4 v0 = *(const f32x4*)(cw + e), v1 = *(const f32x4*)(cw + 2048 + e), v2 = *(const f32x4*)(cw + 4096 + e), v3 = *(const f32x4*)(cw + 6144 + e), vb = *(const f32x4*)(cbp + e);
#pragma unroll
        for (int i = 0; i < 4; ++i) { w0[e + i] = v0[i]; w1[e + i] = v1[i]; w2[e + i] = v2[i]; w3[e + i] = v3[i]; bs[e + i] = vb[i]; }
    }
    const bf16* XBC = (const bf16*)(a.ws + WS_XBC) + (size_t)b * SEQ * 2048 + col;
    const int t0 = c * 128 + 16 * strip;
    float x0[8], x1[8], x2[8], x3[8];
#define SD_LOADROW(dst, t) do { if ((t) >= 0) { const v4u w_ = *(const v4u*)(XBC + (size_t)(t) * 2048); dst[0] = bflo(w_.x); dst[1] = bfhi(w_.x); dst[2] = bflo(w_.y); dst[3] = bfhi(w_.y); \
        dst[4] = bflo(w_.z); dst[5] = bfhi(w_.z); dst[6] = bflo(w_.w); dst[7] = bfhi(w_.w); } else { _Pragma("unroll") for (int e_ = 0; e_ < 8; ++e_) dst[e_] = 0.f; } } while (0)
    SD_LOADROW(x0, t0 - 3); SD_LOADROW(x1, t0 - 2); SD_LOADROW(x2, t0 - 1);
#pragma unroll 4
    for (int rr = 0; rr < 16; ++rr) {
        SD_LOADROW(x3, t0 + rr);
        float o[8];
#pragma unroll
        for (int e = 0; e < 8; ++e) { const float v = bs[e] + w0[e] * x0[e] + w1[e] * x1[e] + w2[e] * x2[e] + w3[e] * x3[e]; o[e] = v * __builtin_amdgcn_rcpf(1.f + __expf(-v)); }
        const int row = 16 * strip + rr;
        v4u pw; pw.x = pkbf(o[0], o[1]); pw.y = pkbf(o[2], o[3]); pw.z = pkbf(o[4], o[5]); pw.w = pkbf(o[6], o[7]);
        *(LAS v4u*)(lds + img + row * rowb + ((ci ^ sdf(row)) * 16)) = pw;
#pragma unroll
        for (int e = 0; e < 8; ++e) { x0[e] = x1[e]; x1[e] = x2[e]; x2[e] = x3[e]; }
    }
#undef SD_LOADROW
}
__device__ __forceinline__ void ssd_acs_tables(const Args& a, LAS unsigned char* lds, int b, int c, int g) {
    const int tid = threadIdx.x, lane = tid & 63, wave = __builtin_amdgcn_readfirstlane(tid >> 6);
    if (wave < 4) {
        const int h = 4 * g + wave;
        const float* DT = (const float*)((unsigned char*)a.out + DO_DT) + (size_t)(b * SEQ + c * 128) * 16 + h;
        const float A = -__expf(a.in[I_ALOG][h]);
        const float d0 = DT[(size_t)lane * 16], d1 = DT[(size_t)(lane + 64) * 16];
        float s0 = d0 * A, s1 = d1 * A;
#pragma unroll
        for (int o = 1; o < 64; o <<= 1) { const float u0 = __shfl_up(s0, o), u1 = __shfl_up(s1, o); if (lane >= o) { s0 += u0; s1 += u1; } }
        s1 += __shfl(s0, 63);
        LAS float* acs = (LAS float*)(lds + SD_ACS) + wave * 128; LAS float* dtl = (LAS float*)(lds + SD_DT) + wave * 128;
        acs[lane] = s0; acs[lane + 64] = s1; dtl[lane] = d0; dtl[lane + 64] = d1;
    }
}
__device__ __forceinline__ void ssd_s1_unit(const Args& a, LAS unsigned char* lds, int b, int c, int g) {
    int tid = threadIdx.x; asm volatile("" : "+v"(tid));
    const int lane = tid & 63, wave = __builtin_amdgcn_readfirstlane(tid >> 6);
    const int n16 = lane & 15, gq = lane >> 4;
    __builtin_amdgcn_s_barrier();
    ssd_conv_fill(a, lds, b, c, g, false);
    ssd_acs_tables(a, lds, b, c, g);
    asm volatile("s_waitcnt vmcnt(0) lgkmcnt(0)" ::: "memory"); __builtin_amdgcn_s_barrier(); asm volatile("" ::: "memory");
    { const int r = tid >> 7, l = tid & 127;
      const LAS float* acs = (const LAS float*)(lds + SD_ACS) + r * 128; const LAS float* dtl = (const LAS float*)(lds + SD_DT) + r * 128;
      const float aend = acs[127];
      ((LAS float*)(lds + SD_W))[r * 128 + l] = __expf(aend - acs[l]) * dtl[l];
      if (l == 0) ((float*)((unsigned char*)a.out + DO_DEC))[(size_t)(b * 32 + c) * 16 + 4 * g + r] = __expf(aend); }
    asm volatile("s_waitcnt lgkmcnt(0)" ::: "memory"); __builtin_amdgcn_s_barrier(); asm volatile("" ::: "memory");
    const int r = wave >> 1, pt0 = 2 * (wave & 1);
    f32x4_t acc[2][8];
#pragma unroll
    for (int i = 0; i < 2; ++i)
#pragma unroll
        for (int nt = 0; nt < 8; ++nt) acc[i][nt] = (f32x4_t){0.f, 0.f, 0.f, 0.f};
    const int q4 = n16 >> 2, pp = n16 & 3;
#pragma unroll 1
    for (int ks = 0; ks < 4; ++ks) {
        const int rowa = 32 * ks + 8 * gq + q4;
        const int fa = sdf(rowa);
        const f32x4_t wl0 = *(const LAS f32x4_t*)(lds + SD_W + (r * 128 + 32 * ks + 8 * gq) * 4), wl1 = *(const LAS f32x4_t*)(lds + SD_W + (r * 128 + 32 * ks + 8 * gq + 4) * 4);
        bf16x8_t af[2];
#pragma unroll
        for (int i = 0; i < 2; ++i) {
            const int cch = 8 * r + 2 * (pt0 + i) + (pp >> 1);
            const LAS unsigned char* ap = lds + SD_X + rowa * 512 + ((cch ^ fa) * 16) + 8 * (pp & 1);
            const s16x4_t v0 = lds_tr16(ap), v1 = lds_tr16(ap + 4 * 512);
            float f[8] = {bf2f((bf16)v0[0]) * wl0[0], bf2f((bf16)v0[1]) * wl0[1], bf2f((bf16)v0[2]) * wl0[2], bf2f((bf16)v0[3]) * wl0[3],
                          bf2f((bf16)v1[0]) * wl1[0], bf2f((bf16)v1[1]) * wl1[1], bf2f((bf16)v1[2]) * wl1[2], bf2f((bf16)v1[3]) * wl1[3]};
            v4u pw; pw.x = pkbf(f[0], f[1]); pw.y = pkbf(f[2], f[3]); pw.z = pkbf(f[4], f[5]); pw.w = pkbf(f[6], f[7]);
            af[i] = __builtin_bit_cast(bf16x8_t, pw);
        }
#pragma unroll
        for (int nt = 0; nt < 8; ++nt) {
            const LAS unsigned char* bp = lds + SD_B + rowa * 256 + (((2 * nt + (pp >> 1)) ^ fa) * 16) + 8 * (pp & 1);
            const s16x4_t v0 = lds_tr16(bp), v1 = lds_tr16(bp + 4 * 256);
            const bf16x8_t bfg = {v0[0], v0[1], v0[2], v0[3], v1[0], v1[1], v1[2], v1[3]};
            acc[0][nt] = __builtin_amdgcn_mfma_f32_16x16x32_bf16(af[0], bfg, acc[0][nt], 0, 0, 0);
            acc[1][nt] = __builtin_amdgcn_mfma_f32_16x16x32_bf16(af[1], bfg, acc[1][nt], 0, 0, 0);
        }
    }
    bf16* ST = (bf16*)((unsigned char*)a.out + DO_ST) + ((size_t)((b * 32 + c) * 16 + 4 * g + r)) * 8192;
#pragma unroll
    for (int i2 = 0; i2 < 2; ++i2)
#pragma unroll
        for (int nt = 0; nt < 8; ++nt)
#pragma unroll
            for (int i = 0; i < 4; ++i) ST[(16 * (pt0 + i2) + 4 * gq + i) * 128 + 16 * nt + n16] = (bf16)f2bf(acc[i2][nt][i]);
    asm volatile("s_waitcnt lgkmcnt(0)" ::: "memory");
}
__device__ __forceinline__ void ssd_s2_scan(const Args& a, int gtid, int NGT) {
    bf16* ST = (bf16*)((unsigned char*)a.out + DO_ST); const float* DEC = (const float*)((unsigned char*)a.out + DO_DEC);
    for (int e = gtid; e < 4 * 16 * 2048; e += NGT) {
        const int b = e >> 15, h = (e >> 11) & 15, qd = e & 2047;
        float h0 = 0.f, h1 = 0.f, h2 = 0.f, h3 = 0.f;
#pragma unroll 4
        for (int c = 0; c < 32; ++c) {
            v2u* p = (v2u*)(ST + ((size_t)((b * 32 + c) * 16 + h)) * 8192 + qd * 4);
            const v2u s = *p; const float d = DEC[(b * 32 + c) * 16 + h];
            v2u o; o.x = pk2(h0, h1); o.y = pk2(h2, h3); *p = o;
            h0 = d * h0 + bflo(s.x); h1 = d * h1 + bfhi(s.x); h2 = d * h2 + bflo(s.y); h3 = d * h3 + bfhi(s.y);
        }
    }
}
__device__ __forceinline__ void ssd_s3_unit(const Args& a, LAS unsigned char* lds, int b, int c, int g) {
    int tid = threadIdx.x; asm volatile("" : "+v"(tid));
    const int lane = tid & 63, wave = __builtin_amdgcn_readfirstlane(tid >> 6);
    const int n16 = lane & 15, gq = lane >> 4;
    __builtin_amdgcn_s_barrier();
    ssd_conv_fill(a, lds, b, c, g, true);
    ssd_acs_tables(a, lds, b, c, g);
    asm volatile("s_waitcnt vmcnt(0) lgkmcnt(0)" ::: "memory"); __builtin_amdgcn_s_barrier(); asm volatile("" ::: "memory");
    const int l0 = 16 * wave, lrow = l0 + n16;
    const LAS float* ACS = (const LAS float*)(lds + SD_ACS); const LAS float* DTL = (const LAS float*)(lds + SD_DT);
    bf16x8_t cfr[4];
    { const int fl = sdf(lrow);
#pragma unroll
      for (int ks = 0; ks < 4; ++ks) cfr[ks] = *(const LAS bf16x8_t*)(lds + SD_C + lrow * 256 + (((4 * ks + gq) ^ fl) * 16)); }
    float acl[4];
#pragma unroll
    for (int r = 0; r < 4; ++r) acl[r] = ACS[r * 128 + lrow];
    f32x4_t Y[4][4];
#pragma unroll
    for (int r = 0; r < 4; ++r)
#pragma unroll
        for (int pt = 0; pt < 4; ++pt) Y[r][pt] = (f32x4_t){0.f, 0.f, 0.f, 0.f};
    const int kap = 8 * (n16 >> 2) + (n16 & 3), fk = sdf(kap);
    const int tq4 = n16 >> 2, tp = n16 & 3;
    const int nch = (wave >> 1) + 1;
#pragma unroll 1
    for (int ch = 0; ch < nch; ++ch) {
        f32x4_t sa = {0.f, 0.f, 0.f, 0.f}, sb = {0.f, 0.f, 0.f, 0.f};
#pragma unroll
        for (int ks = 0; ks < 4; ++ks) {
            const int slot = (4 * ks + gq) ^ fk;
            const bf16x8_t ba = *(const LAS bf16x8_t*)(lds + SD_B + (32 * ch + kap) * 256 + slot * 16), bb = *(const LAS bf16x8_t*)(lds + SD_B + (32 * ch + kap + 4) * 256 + slot * 16);
            sa = __builtin_amdgcn_mfma_f32_16x16x32_bf16(ba, cfr[ks], sa, 0, 0, 0);
            sb = __builtin_amdgcn_mfma_f32_16x16x32_bf16(bb, cfr[ks], sb, 0, 0, 0);
        }
        const int s0 = 32 * ch + 8 * gq;
        const int trow = s0 + tq4, tf = sdf(trow);
#pragma unroll
        for (int r = 0; r < 4; ++r) {
            const f32x4_t as0 = *(const LAS f32x4_t*)(ACS + r * 128 + s0), as1 = *(const LAS f32x4_t*)(ACS + r * 128 + s0 + 4);
            const f32x4_t dt0 = *(const LAS f32x4_t*)(DTL + r * 128 + s0), dt1 = *(const LAS f32x4_t*)(DTL + r * 128 + s0 + 4);
            float gj[8];
#pragma unroll
            for (int j = 0; j < 4; ++j) {
                gj[j]     = (s0 + j     <= lrow) ? sa[j] * __expf(fminf(acl[r] - as0[j], 0.f)) * dt0[j] : 0.f;
                gj[4 + j] = (s0 + 4 + j <= lrow) ? sb[j] * __expf(fminf(acl[r] - as1[j], 0.f)) * dt1[j] : 0.f;
            }
            v4u pw; pw.x = pkbf(gj[0], gj[1]); pw.y = pkbf(gj[2], gj[3]); pw.z = pkbf(gj[4], gj[5]); pw.w = pkbf(gj[6], gj[7]);
            const bf16x8_t pf = __builtin_bit_cast(bf16x8_t, pw);
#pragma unroll
            for (int pt = 0; pt < 4; ++pt) {
                const LAS unsigned char* xp = lds + SD_X + trow * 512 + (((8 * r + 2 * pt + (tp >> 1)) ^ tf) * 16) + 8 * (tp & 1);
                const s16x4_t v0 = lds_tr16(xp), v1 = lds_tr16(xp + 4 * 512);
                const bf16x8_t vb = {v0[0], v0[1], v0[2], v0[3], v1[0], v1[1], v1[2], v1[3]};
                Y[r][pt] = __builtin_amdgcn_mfma_f32_16x16x32_bf16(pf, vb, Y[r][pt], 0, 0, 0);
            }
        }
    }
    const bf16* ST = (const bf16*)((unsigned char*)a.out + DO_ST) + ((size_t)((b * 32 + c) * 16 + 4 * g)) * 8192;
    bf16* ZS = (bf16*)(a.ws + WS_Z) + (size_t)(b * SEQ + c * 128 + l0) * 1024 + g * 256;
    float ssq[4] = {0.f, 0.f, 0.f, 0.f};
#pragma unroll
    for (int r = 0; r < 4; ++r) {
        f32x4_t acc2[4];
#pragma unroll
        for (int pt = 0; pt < 4; ++pt) acc2[pt] = (f32x4_t){0.f, 0.f, 0.f, 0.f};
        const bf16* hp = ST + (size_t)r * 8192 + (size_t)n16 * 128 + 8 * gq;
#pragma unroll
        for (int ks = 0; ks < 4; ++ks)
#pragma unroll
            for (int pt = 0; pt < 4; ++pt) { const bf16x8_t hf = *(const bf16x8_t*)(hp + (size_t)pt * 16 * 128 + 32 * ks); acc2[pt] = __builtin_amdgcn_mfma_f32_16x16x32_bf16(cfr[ks], hf, acc2[pt], 0, 0, 0); }
        __builtin_amdgcn_sched_barrier(0);
        const float Dsk = a.in[I_DSKIP][4 * g + r];
#pragma unroll
        for (int i = 0; i < 4; ++i) {
            const int li = l0 + 4 * gq + i; const float ea = __expf(ACS[r * 128 + li]); const int fx = sdf(li);
#pragma unroll
            for (int pt = 0; pt < 4; ++pt) {
                const int colx = r * 64 + 16 * pt + n16;
                const float xv = bf2f(*(const LAS unsigned short*)(lds + SD_X + li * 512 + (((colx >> 3) ^ fx) * 16) + (colx & 7) * 2));
                const float zv = bf2f(ZS[(size_t)(4 * gq + i) * 1024 + colx]);
                const float v = (Y[r][pt][i] + ea * acc2[pt][i] + Dsk * xv) * zv;
                Y[r][pt][i] = v; ssq[i] += v * v;
            }
        }
        __builtin_amdgcn_sched_barrier(0);
    }
    const float* nw = a.in[I_SSDNW] + g * 256;
#pragma unroll
    for (int i = 0; i < 4; ++i) {
        float s = ssq[i];
        s += __shfl_xor(s, 1); s += __shfl_xor(s, 2); s += __shfl_xor(s, 4); s += __shfl_xor(s, 8);
        const float rs = 1.f / sqrtf(s * (1.f / 256.f) + RMS_EPS);
#pragma unroll
        for (int r = 0; r < 4; ++r)
#pragma unroll
            for (int pt = 0; pt < 4; ++pt) { const int colx = r * 64 + 16 * pt + n16; ZS[(size_t)(4 * gq + i) * 1024 + colx] = (bf16)f2bf(Y[r][pt][i] * rs * nw[colx]); }
    }
    asm volatile("s_waitcnt lgkmcnt(0)" ::: "memory");
}

enum { PH_PREP = 0, PH_FFN1_IN, PH_FFN1_OUT, PH_LN1, PH_INPROJ, PH_SSD_SCAN, PH_SSD_S2, PH_SSD_NORM, PH_INDEXER, PH_ATTN, PH_MERGE, PH_WOUT, PH_LN2, PH_QM, PH_MEMATTN, PH_WMO, PH_LN3,
       PH_FFN2_IN, PH_FFN2_OUT, PH_LN4, N_PHASES };

template <class Epi> __device__ __forceinline__ void run_gemm(LAS unsigned char* lds, const bf16* A, const bf16* Bt, int M, int N, int K, const Epi& E) {
    pg8::Gemm g{A, Bt, M, N, K}; pg8::StaticOrder S; S.init(M, N, (int)gridDim.x, (int)blockIdx.x);
    pg8::gemm_phase<Epi, pg8::StaticOrder, true, true>(lds, g, S, E);
}

template <int ph> __device__ __forceinline__ void run_phase(const Args& a, unsigned char* lds) {
    LAS unsigned char* ldsl = (LAS unsigned char*)lds;
    const int tid = threadIdx.x, lane = tid & 63, wave = __builtin_amdgcn_readfirstlane(tid >> 6);
    const int G = gridDim.x, bx = blockIdx.x;
    const int gw = bx * NWAVES + wave, NGW = G * NWAVES, gtid = bx * NTHR + tid, NGT = G * NTHR;
    unsigned char* ws = a.ws; unsigned char* dob = (unsigned char*)a.out;
    bf16* XB = (bf16*)(ws + WS_XB);
    {
        switch (ph) {
        case PH_PREP: {
            float* scr = (float*)(lds + wave * 16384);
            int base = 0;
            run_tr(a.in[I_F1IN], 1024, 2 * DFF, (bf16*)(ws + WS_WA_IN), 2 * DFF, 1, scr, gw, NGW, lane, base);
            run_tr(a.in[I_F1OUT], DFF, 1024, (bf16*)(ws + WS_WA_OUT), 1024, 0, scr, gw, NGW, lane, base);
            run_tr(a.in[I_WIN], 1024, WIN_LD, (bf16*)(ws + WS_WIN), NIN, 2, scr, gw, NGW, lane, base);
            run_tr(a.in[I_WIN], 1024, WIN_LD, (bf16*)(ws + WS_WGS), 1024, 3, scr, gw, NGW, lane, base);
            run_tr(a.in[I_WIN], 1024, WIN_LD, (bf16*)(ws + WS_WGA), 1024, 4, scr, gw, NGW, lane, base);
            run_tr(a.in[I_WPS], 1024, 1024, (bf16*)(ws + WS_WPS), 1024, 0, scr, gw, NGW, lane, base);
            run_tr(a.in[I_WPA], 1024, 1024, (bf16*)(ws + WS_WPA), 1024, 0, scr, gw, NGW, lane, base);
            run_tr(a.in[I_WOUT], 1024, 1024, (bf16*)(ws + WS_WOUT), 1024, 0, scr, gw, NGW, lane, base);
            run_tr(a.in[I_WMQ], 1024, 1024, (bf16*)(ws + WS_WMQ), 1024, 0, scr, gw, NGW, lane, base);
            run_tr(a.in[I_WMO], 1024, 1024, (bf16*)(ws + WS_WMO), 1024, 0, scr, gw, NGW, lane, base);
            run_tr(a.in[I_WMKV], 1024, 2048, (bf16*)(ws + WS_WMKV), 2048, 0, scr, gw, NGW, lane, base);
            for (int h = 0; h < 16; ++h) {
                run_tr(a.in[I_WUK] + (size_t)h * 64 * 256, 64, 256, (bf16*)(ws + WS_WUK) + (size_t)h * 256 * 64, 256, 0, scr, gw, NGW, lane, base, 0.125f);
                run_tr(a.in[I_WUV] + (size_t)h * 256 * 64, 256, 64, (bf16*)(ws + WS_WUK) + (size_t)16 * 256 * 64 + (size_t)h * 64 * 256, 64, 0, scr, gw, NGW, lane, base);
            }
            cvt_rows(a.in[I_X], XB, (size_t)T * D / 4, gtid, NGT);
            cvt_rows(a.in[I_MEM], (bf16*)(ws + WS_MEMB), (size_t)BATCH * MEML * D / 4, gtid, NGT);
        } break;
        case PH_FFN1_IN: {
            pg8::EpiSwiglu E{(bf16*)(ws + WS_H), DFF};
            run_gemm(ldsl, XB, (const bf16*)(ws + WS_WA_IN), T, 2 * DFF, D, E);
            pg8::EpiPlain E2{(bf16*)(ws + WS_KVM), 2048};
            run_gemm(ldsl, (const bf16*)(ws + WS_MEMB), (const bf16*)(ws + WS_WMKV), BATCH * MEML, 2048, D, E2);
        } break;
        case PH_FFN1_OUT: {
            pg8::EpiRes<false> E{a.in[I_X], (float*)dob, ALPHA, 0.5f};
            run_gemm(ldsl, (const bf16*)(ws + WS_H), (const bf16*)(ws + WS_WA_OUT), T, D, DFF, E);
        } break;
        case PH_LN1: ln_rows((const float*)dob, a.in[I_LN1G], a.in[I_LN1B], XB, nullptr, gw, NGW, lane); break;
        case PH_INPROJ: {
            pg8::EpiInproj E{(bf16*)(ws + WS_Z), (bf16*)(ws + WS_XBC), (bf16*)(ws + WS_Q), (bf16*)(ws + WS_QI), (bf16*)(ws + WS_KIDX),
                             (float*)(dob + DO_CKV), (float*)(dob + DO_DT), (float*)(dob + DO_WIDX), a.in[I_DTB]};
            run_gemm(ldsl, XB, (const bf16*)(ws + WS_WIN), T, NIN, D, E);
            __syncthreads();
            float* scr = (float*)(lds + wave * 16384);
            int base = 0;
            run_tr(a.in[I_F2IN], 1024, 2 * DFF, (bf16*)(ws + WS_WA_IN), 2 * DFF, 1, scr, gw, NGW, lane, base);
            run_tr(a.in[I_F2OUT], DFF, 1024, (bf16*)(ws + WS_WA_OUT), 1024, 0, scr, gw, NGW, lane, base);
        } break;
        case PH_SSD_SCAN: {
            for (int u = bx; u < 512; u += G) ssd_s1_unit(a, ldsl, u >> 7, (u >> 2) & 31, u & 3);
            ckv_norm(a, gw, NGW, lane);
        } break;
        case PH_SSD_S2: ssd_s2_scan(a, gtid, NGT); break;
        case PH_SSD_NORM: { for (int u = bx; u < 512; u += G) ssd_s3_unit(a, ldsl, u >> 7, (u >> 2) & 31, u & 3); } break;
        case PH_INDEXER: {
            for (int id = bx; id < 1024; id += G) { const int b = id >> 8, wq = id & 255, blk = (b & 1) ? 255 - wq : wq;
                __builtin_amdgcn_s_barrier();
                indexer_task(a, ldsl, b, blk); }
        } break;
        case PH_ATTN: {
            for (int it = 0; it < 2048; it += G) { const int id = it + bx; if (id >= 2048) break;
                const int w8 = id & 7, rest = id >> 3;
                const int bseq = w8 >> 1, qb = (w8 & 1) * 256 + rest;
                attn_batch(a, ldsl, bseq * SEQ + qb * 8); }
        } break;
        case PH_MERGE: {
            bf16* Sg1 = (bf16*)(ws + WS_QI); bf16* Sg2 = (bf16*)(dob + DO_SG2); float* Sm = (float*)(ws + WS_XBC); bf16* MG = (bf16*)(dob + DO_MERGED);
            { pg8::EpiMerge<0> E{Sg1, Sm, MG}; run_gemm(ldsl, XB, (const bf16*)(ws + WS_WGS), T, D, D, E); }
            { pg8::EpiMerge<1> E{Sg1, Sm, MG}; run_gemm(ldsl, (const bf16*)(ws + WS_Z), (const bf16*)(ws + WS_WPS), T, D, D, E); }
            { pg8::EpiMerge<0> E{Sg2, Sm, MG}; run_gemm(ldsl, XB, (const bf16*)(ws + WS_WGA), T, D, D, E); }
            { pg8::EpiMerge<2> E{Sg2, Sm, MG}; run_gemm(ldsl, (const bf16*)(ws + WS_Q), (const bf16*)(ws + WS_WPA), T, D, D, E); }
        } break;
        case PH_WOUT: {
            pg8::EpiRes<true> E{XB, (float*)(ws + WS_XBC), ALPHA, 1.0f};
            run_gemm(ldsl, (const bf16*)(dob + DO_MERGED), (const bf16*)(ws + WS_WOUT), T, D, D, E);
        } break;
        case PH_LN2: ln_rows((const float*)(ws + WS_XBC), a.in[I_LN2G], a.in[I_LN2B], XB, nullptr, gw, NGW, lane); break;
        case PH_QM: {
            pg8::EpiPlain E{(bf16*)(ws + WS_Z), 1024};
            run_gemm(ldsl, XB, (const bf16*)(ws + WS_WMQ), T, D, D, E);
        } break;
        case PH_MEMATTN: {
            for (int u = bx; u < 512; u += G) { const int b = u >> 7, hd = (u >> 5) & 3, qblk = u & 31; memattn_unit(a, ldsl, b, hd, qblk); }
        } break;
        case PH_WMO: {
            pg8::EpiRes<true> E{XB, (float*)dob, ALPHA, 1.0f};
            run_gemm(ldsl, (const bf16*)(ws + WS_Z), (const bf16*)(ws + WS_WMO), T, D, D, E);
        } break;
        case PH_LN3: ln_rows((const float*)dob, a.in[I_LN3G], a.in[I_LN3B], XB, nullptr, gw, NGW, lane); break;
        case PH_FFN2_IN: {
            pg8::EpiSwiglu E{(bf16*)(ws + WS_H), DFF};
            run_gemm(ldsl, XB, (const bf16*)(ws + WS_WA_IN), T, 2 * DFF, D, E);
        } break;
        case PH_FFN2_OUT: {
            pg8::EpiRes<true> E{XB, (float*)dob, ALPHA, 0.5f};
            run_gemm(ldsl, (const bf16*)(ws + WS_H), (const bf16*)(ws + WS_WA_OUT), T, D, DFF, E);
        } break;
        case PH_LN4: ln_rows((const float*)dob, a.in[I_LN4G], a.in[I_LN4B], nullptr, (float*)dob, gw, NGW, lane); break;
        default: break;
        }
    }
}

template <int PH> __global__ void __launch_bounds__(NTHR, 2) k_phase(Args a) {
    extern __shared__ __attribute__((aligned(16))) unsigned char lds[];
    run_phase<PH>(a, lds);
}
template <int PH> __device__ __forceinline__ void mega_phases(const Args& a, unsigned char* lds, cooperative_groups::grid_group& grid) {
    if constexpr (PH < N_PHASES) {
        if (PH >= a.ph_lo && PH < a.ph_hi) { run_phase<PH>(a, lds); if (PH + 1 < a.ph_hi) grid.sync(); }
        mega_phases<PH + 1>(a, lds, grid);
    }
}
__global__ void __launch_bounds__(NTHR, 2) hybrid_mega(Args a) {
    extern __shared__ __attribute__((aligned(16))) unsigned char lds[];
    cooperative_groups::grid_group grid = cooperative_groups::this_grid();
    mega_phases<0>(a, lds, grid);
}
#ifndef MEGA
#define MEGA 1
#endif
template <int PH> static void launch_phase(const Args& a, int grid, hipStream_t stream) {
    static bool attr = false;
    if (!attr) { (void)hipFuncSetAttribute((const void*)k_phase<PH>, hipFuncAttributeMaxDynamicSharedMemorySize, LDS_BYTES); attr = true; }
    hipLaunchKernelGGL(k_phase<PH>, dim3(grid), dim3(NTHR), LDS_BYTES, stream, a);
}
template <int PH> static void launch_all(const Args& a, int grid, hipStream_t stream) {
    if constexpr (PH < N_PHASES) { launch_phase<PH>(a, grid, stream); launch_all<PH + 1>(a, grid, stream); }
}

#ifndef CUT_PHASE
#define CUT_PHASE -1
#endif
#ifndef CUT_SRC
#define CUT_SRC WS_XB
#endif
__global__ void __launch_bounds__(NTHR) k_dump(Args a) {
    const bf16* src = (const bf16*)(a.ws + CUT_SRC);
    const size_t n = (size_t)T * D;
    for (size_t i = (size_t)blockIdx.x * NTHR + threadIdx.x; i < n; i += (size_t)gridDim.x * NTHR) a.out[i] = bf2f(src[i]);
}
template <int PH> static void launch_upto(const Args& a, int grid, hipStream_t stream) {
    if constexpr (PH < N_PHASES) { if (PH <= CUT_PHASE) { launch_phase<PH>(a, grid, stream); launch_upto<PH + 1>(a, grid, stream); } }
}

extern "C" void kernel_launch(void* const* d_in, const int* in_sizes, int n_in, void* d_out, int out_size, void* d_ws, size_t ws_size, hipStream_t stream) {
    static int grid = 0;
    if (grid == 0) {
        if (n_in != 30 || out_size != T * D || ws_size < WS_END) { fprintf(stderr, "kernel_launch: unexpected shapes n_in %d out %d ws %zu\n", n_in, out_size, ws_size); grid = -1; return; }
        grid = 256;
    }
    if (grid < 0) return;
    Args a{};
    for (int i = 0; i < 30; ++i) a.in[i] = (const float*)d_in[i];
    a.out = (float*)d_out; a.ws = (unsigned char*)d_ws;
    a.ph_lo = 0; a.ph_hi = N_PHASES;
    if (MEGA) {
        static bool attr = false;
        if (!attr) {
            (void)hipFuncSetAttribute((const void*)hybrid_mega, hipFuncAttributeMaxDynamicSharedMemorySize, LDS_BYTES);
            int per_cu = 0; (void)hipOccupancyMaxActiveBlocksPerMultiprocessor(&per_cu, (const void*)hybrid_mega, NTHR, LDS_BYTES);
            if (per_cu < 1) fprintf(stderr, "kernel_launch: occupancy query says %d blocks per CU\n", per_cu);
            attr = true;
        }
        void* args[] = {&a};
        hipError_t e = hipLaunchCooperativeKernel((const void*)hybrid_mega, dim3(grid), dim3(NTHR), args, LDS_BYTES, stream);
        if (e != hipSuccess) fprintf(stderr, "cooperative launch failed: %s\n", hipGetErrorString(e));
    } else if (CUT_PHASE < 0) launch_all<0>(a, grid, stream);
    else { launch_upto<0>(a, grid, stream); hipLaunchKernelGGL(k_dump, dim3(1024), dim3(NTHR), 0, stream, a); }
}
```
